# Optimizing an MI355X kernel written in HIP

```python
import math
import jax, jax.numpy as jnp
from jax import lax
import numpy as np

D_MODEL = 2048
BATCH = 8
SEQ = 4096
DEPTH = 4

HEAD_DIM = 64
N_HEADS_TOTAL = D_MODEL // HEAD_DIM
N_HEADS_A = N_HEADS_TOTAL // 4
N_KV_A = N_HEADS_A // 4
N_HEADS_B = N_HEADS_TOTAL // 4
N_HEADS_C = N_HEADS_TOTAL // 2
BLOCK = 128
WINDOW_A = 128
DILATED_PAIRS = ((128, 1), (512, 4), (2048, 16))
N_BUCKETS = 32
T5_MAX_DIST = 2048
D_FF = 256 * (-(-(8 * D_MODEL // 3) // 256))
CONV_WIDTH = 3
EPS = 1e-6
NEG_INF = -1e30

A_Q = N_HEADS_A * HEAD_DIM
A_KV = N_KV_A * HEAD_DIM
B_W = N_HEADS_B * HEAD_DIM
C_W = N_HEADS_C * HEAD_DIM
IN_WIDTH = A_Q + 2 * A_KV + 3 * B_W + 3 * C_W
MIX_WIDTH = A_Q + B_W + C_W

kernel_name = "hymba_style_swa_stickbreak_dilated_convffn"


def rmsnorm(x, g):
    xf = x.astype(jnp.float32)
    y = xf * lax.rsqrt(jnp.mean(xf * xf, axis=-1, keepdims=True) + EPS)
    return (y * g.astype(jnp.float32)).astype(x.dtype)


def t5_bucket(dist):
    max_exact = N_BUCKETS // 2
    d = jnp.maximum(dist, 0)
    large = max_exact + (jnp.log(jnp.maximum(d, 1).astype(jnp.float32) / max_exact)
                         / math.log(T5_MAX_DIST / max_exact) * (N_BUCKETS - max_exact)).astype(jnp.int32)
    large = jnp.minimum(large, N_BUCKETS - 1)
    return jnp.where(d < max_exact, d, large)


def block_rel_bias(table, dil):
    rel = jnp.arange(BLOCK)[:, None] + BLOCK - jnp.arange(2 * BLOCK)[None, :]
    buckets = t5_bucket(rel * dil)
    return jnp.transpose(table[buckets], (2, 0, 1)).astype(jnp.float32)


def banded_attention(q, k, v, bias, max_dist, sinks=None):
    n, length, hq, hd = q.shape
    hk = k.shape[2]
    grp = hq // hk
    lp = -(-length // BLOCK) * BLOCK
    if lp != length:
        padw = ((0, 0), (0, lp - length), (0, 0), (0, 0))
        q, k, v = jnp.pad(q, padw), jnp.pad(k, padw), jnp.pad(v, padw)
    nb = lp // BLOCK
    qb = q.reshape(n, nb, BLOCK, hk, grp, hd).astype(jnp.float32)
    kb = k.reshape(n, nb, BLOCK, hk, hd).astype(jnp.float32)
    vb = v.reshape(n, nb, BLOCK, hk, hd).astype(jnp.float32)
    prev = ((0, 0), (1, 0), (0, 0), (0, 0), (0, 0))
    kk = jnp.concatenate([jnp.pad(kb[:, :-1], prev), kb], axis=2)
    vv = jnp.concatenate([jnp.pad(vb[:, :-1], prev), vb], axis=2)
    logits = (jnp.einsum('nbqhgd,nbkhd->nbhgqk', qb, kk) * (hd ** -0.5)
              + bias.reshape(hk, grp, BLOCK, 2 * BLOCK))
    rel = jnp.arange(BLOCK)[:, None] + BLOCK - jnp.arange(2 * BLOCK)[None, :]
    key_abs = (jnp.arange(nb)[:, None] - 1) * BLOCK + jnp.arange(2 * BLOCK)[None, :]
    mask = ((rel >= 0) & (rel <= max_dist))[None] & (key_abs >= 0)[:, None, :]
    logits = jnp.where(mask[None, :, None, None], logits, NEG_INF)
    m = jnp.max(logits, axis=-1, keepdims=True)
    if sinks is not None:
        s = sinks.astype(jnp.float32).reshape(hk, grp, 1, 1)
        m = jnp.maximum(m, s)
    p = jnp.exp(logits - m)
    denom = jnp.sum(p, axis=-1, keepdims=True)
    if sinks is not None:
        denom = denom + jnp.exp(s - m)
    out = jnp.einsum('nbhgqk,nbkhd->nbhgqd', p / denom, vv)
    out = jnp.transpose(out, (0, 1, 4, 2, 3, 5)).reshape(n, lp, hq, hd)[:, :length]
    lse = jnp.transpose((m + jnp.log(denom))[..., 0], (0, 1, 4, 2, 3)).reshape(n, lp, hq)[:, :length]
    return out, lse


def stick_breaking_attention(q, k, v):
    b_, s_, h, hd = q.shape
    nb = s_ // BLOCK
    qb = jnp.transpose(q.reshape(b_, nb, BLOCK, h, hd), (1, 0, 2, 3, 4))
    kf = k.astype(jnp.float32)
    vf = v.astype(jnp.float32)
    s_pos = jnp.arange(s_)

    def one_block(args):
        qblk, blk = args
        z = jnp.einsum('bqhd,bkhd->bhqk', qblk.astype(jnp.float32), kf) * (hd ** -0.5)
        t_pos = blk * BLOCK + jnp.arange(BLOCK)
        causal = s_pos[None, :] < t_pos[:, None]
        log_rem = jnp.where(causal, jax.nn.log_sigmoid(-z), 0.0)
        suffix = lax.cumsum(log_rem, axis=3, reverse=True) - log_rem
        a = jnp.where(causal, jnp.exp(jax.nn.log_sigmoid(z) + suffix), 0.0)
        return jnp.einsum('bhqk,bkhd->bqhd', a, vf)

    out = lax.map(one_block, (qb, jnp.arange(nb)))
    return jnp.transpose(out, (1, 0, 2, 3, 4)).reshape(b_, s_, h, hd)


def dilated_attention(q, k, v, table_c):
    b_, s_, h, hd = q.shape
    outs, lses = [], []
    for window, dil in DILATED_PAIRS:
        def to_sub(t):
            return jnp.transpose(t.reshape(b_, s_ // dil, dil, h, hd), (0, 2, 1, 3, 4)).reshape(b_ * dil, s_ // dil, h, hd)
        o, lse = banded_attention(to_sub(q), to_sub(k), to_sub(v), block_rel_bias(table_c, dil), window // dil)
        outs.append(jnp.transpose(o.reshape(b_, dil, s_ // dil, h, hd), (0, 2, 1, 3, 4)).reshape(b_, s_, h, hd))
        lses.append(jnp.transpose(lse.reshape(b_, dil, s_ // dil, h), (0, 2, 1, 3)).reshape(b_, s_, h))
    w = jax.nn.softmax(jnp.stack(lses, axis=0), axis=0)
    return jnp.sum(w[..., None] * jnp.stack(outs, axis=0), axis=0)


def causal_dwconv(u, w, b):
    up = jnp.pad(u, ((0, 0), (CONV_WIDTH - 1, 0), (0, 0)))
    s_ = u.shape[1]
    acc = b
    for i in range(CONV_WIDTH):
        acc = acc + w[i] * up[:, i:i + s_]
    return acc


def setup_inputs(seed: int = 0) -> dict:
    key = jax.random.key(seed)
    ks = jax.random.split(key, 20)
    f32 = jnp.float32

    def nrm(k, shape, scale):
        return jax.random.normal(k, shape, f32) * scale

    return {
        "x": nrm(ks[0], (BATCH, SEQ, D_MODEL), 1.0),
        "attn_norm": 1.0 + nrm(ks[1], (DEPTH, D_MODEL), 0.02),
        "w_in": nrm(ks[2], (DEPTH, D_MODEL, IN_WIDTH), D_MODEL ** -0.5),
        "a_q_gain": 1.0 + nrm(ks[3], (DEPTH, HEAD_DIM), 0.02),
        "a_k_gain": 1.0 + nrm(ks[4], (DEPTH, HEAD_DIM), 0.02),
        "a_sinks": nrm(ks[5], (DEPTH, N_HEADS_A), 0.5),
        "c_q_gain": 1.0 + nrm(ks[6], (DEPTH, HEAD_DIM), 0.02),
        "c_k_gain": 1.0 + nrm(ks[7], (DEPTH, HEAD_DIM), 0.02),
        "rel_bias_table": nrm(ks[8], (N_BUCKETS, N_HEADS_A + N_HEADS_C), 0.5),
        "mix_out_gain": 1.0 + nrm(ks[9], (DEPTH, MIX_WIDTH), 0.02),
        "w_out": nrm(ks[10], (DEPTH, MIX_WIDTH, D_MODEL), MIX_WIDTH ** -0.5),
        "ffn_norm": 1.0 + nrm(ks[11], (DEPTH, D_MODEL), 0.02),
        "w_up": nrm(ks[12], (DEPTH, D_MODEL, 2 * D_FF), D_MODEL ** -0.5),
        "conv_w": nrm(ks[13], (DEPTH, CONV_WIDTH, 2 * D_FF), CONV_WIDTH ** -0.5),
        "conv_b": nrm(ks[14], (DEPTH, 2 * D_FF), 0.02),
        "w_down": nrm(ks[15], (DEPTH, D_FF, D_MODEL), D_FF ** -0.5),
    }


def reference(x, attn_norm, w_in, a_q_gain, a_k_gain, a_sinks, c_q_gain, c_k_gain, rel_bias_table,
              mix_out_gain, w_out, ffn_norm, w_up, conv_w, conv_b, w_down):
    b_, s_, _ = x.shape
    sizes = [A_Q, A_KV, A_KV, B_W, B_W, B_W, C_W, C_W, C_W]
    offsets = [int(o) for o in np.cumsum(sizes)[:-1]]
    table_a = rel_bias_table[:, :N_HEADS_A]
    table_c = rel_bias_table[:, N_HEADS_A:]
    bias_a = block_rel_bias(table_a, 1)
    for l in range(DEPTH):
        h = rmsnorm(x, attn_norm[l])
        proj = jnp.einsum('bsd,de->bse', h, w_in[l])
        aq, ak, av, bq, bk, bv, cq, ck, cv = jnp.split(proj, offsets, axis=-1)
        heads = lambda t, n: t.reshape(b_, s_, n, HEAD_DIM)
        out_a, _ = banded_attention(rmsnorm(heads(aq, N_HEADS_A), a_q_gain[l]),
                                    rmsnorm(heads(ak, N_KV_A), a_k_gain[l]),
                                    heads(av, N_KV_A), bias_a, WINDOW_A - 1, sinks=a_sinks[l])
        out_b = stick_breaking_attention(heads(bq, N_HEADS_B), heads(bk, N_HEADS_B), heads(bv, N_HEADS_B))
        out_c = dilated_attention(rmsnorm(heads(cq, N_HEADS_C), c_q_gain[l]),
                                  rmsnorm(heads(ck, N_HEADS_C), c_k_gain[l]),
                                  heads(cv, N_HEADS_C), table_c)
        g = mix_out_gain[l]
        ya = rmsnorm(out_a.reshape(b_, s_, A_Q), g[:A_Q])
        yb = rmsnorm(out_b.reshape(b_, s_, B_W), g[A_Q:A_Q + B_W])
        yc = rmsnorm(out_c.reshape(b_, s_, C_W), g[A_Q + B_W:])
        mix = jnp.concatenate([ya, yb, yc], axis=-1).astype(x.dtype)
        x = x + jnp.einsum('bse,ed->bsd', mix, w_out[l])
        h = rmsnorm(x, ffn_norm[l])
        u = causal_dwconv(jnp.einsum('bsd,df->bsf', h, w_up[l]), conv_w[l], conv_b[l])
        gate, up = jnp.split(u, [D_FF], axis=-1)
        x = x + jnp.einsum('bsf,fd->bsd', jax.nn.silu(gate) * up, w_down[l])
    return x
```

```cpp
#include <hip/hip_runtime.h>
#include <hip/hip_cooperative_groups.h>
#include <cstdio>
#include <cstdint>
namespace cg = cooperative_groups;
#define WGM_IN 4
#define WGM_OUT 4
#define WGM_UP 4
#define WGM_DOWN 2
namespace pg8 {
#define PG8_LAS __attribute__((address_space(3)))
typedef unsigned short bf16_t;
typedef short bf16x8 __attribute__((ext_vector_type(8)));
typedef float f32x4 __attribute__((ext_vector_type(4)));
typedef unsigned u32x4 __attribute__((ext_vector_type(4)));
constexpr int BM = 256, BK = 64, HALF = 128, HTB = HALF * BK * 2  , STAGE_BYTES = 8 * HTB, NXCD = 8, WGM = 8;

__host__ __device__ __forceinline__ int lds_byte(int r, int c) { const int st = (r >> 4) * 2 + (c >> 5), rr = r & 15, cc = c & 31, ob = rr * 64 + cc * 2; return st * 1024 + (ob ^ (((ob >> 9) & 1) << 5)); }
__host__ __device__ __forceinline__ void stage_rc(int b, int& R, int& C) { const int st = b / 1024, sb = b % 1024, swz = sb ^ (((sb >> 9) & 1) << 5); R = (st >> 1) * 16 + swz / 64; C = (st & 1) * 32 + (swz % 64) / 2; }
__host__ __device__ __forceinline__ int perm32(int rho) { const int n = rho >> 4, i = rho & 15; return 8 * (i >> 2) + 4 * n + (i & 3); }

struct Unit { int pm, pn; };
struct Gemm { const bf16_t* A; const bf16_t* Bt; int M, N, K; };

struct StaticOrder {
    int nM, nN, nwg, G, c, wgm, rev;
    __host__ __device__ void init(int M, int N, int G_, int c_, int wgm_ = 4, int rev_ = 0) { nM = M / BM; nN = N / BM; nwg = nM * nN; G = G_; c = c_; wgm = wgm_; rev = rev_; }
    __host__ __device__ bool next(int i, Unit& u) const {
        const long L = (long)i * G + c; if (L >= nwg) return false;
        int wgid = (int)L; { const int q = nwg / NXCD, r = nwg % NXCD, xcd = wgid % NXCD, off = wgid / NXCD; wgid = (xcd < r ? xcd * (q + 1) : r * (q + 1) + (xcd - r) * q) + off; }
        const int nig = wgm * nN, gid = wgid / nig, fm = gid * wgm, gsz = (nM - fm) < wgm ? (nM - fm) : wgm;
        u.pm = fm + ((wgid % nig) % gsz); u.pn = (wgid % nig) / gsz; if (rev) u.pm = nM - 1 - u.pm; return true;
    }
    __device__ __forceinline__ void a_ready(const Unit&) const {}
    __device__ __forceinline__ void done(const Unit&) const {}
};

__device__ __forceinline__ unsigned cvt_pk_bf16(float lo, float hi) { unsigned r; asm volatile("v_cvt_pk_bf16_f32 %0, %1, %2" : "=v"(r) : "v"(lo), "v"(hi)); return r; }
typedef float f32x2 __attribute__((ext_vector_type(2)));
typedef unsigned u32x2 __attribute__((ext_vector_type(2)));
__device__ __forceinline__ float row_rstd(const float* rsp, int row, int fq) {
    const f32x4 a = *(const f32x4*)(rsp + (size_t)row * 32 + 8 * fq), b = *(const f32x4*)(rsp + (size_t)row * 32 + 8 * fq + 4);
    float s = ((a[0] + a[1]) + (a[2] + a[3])) + ((b[0] + b[1]) + (b[2] + b[3]));
    s += __shfl_xor(s, 16); s += __shfl_xor(s, 32);
    return 1.0f / sqrtf(s * (1.0f / 2048.0f) + 1e-6f);
}
__device__ __forceinline__ float sum_fq(float v) {
    const auto a = __builtin_amdgcn_permlane16_swap(__float_as_uint(v), __float_as_uint(v), false, false); v = __uint_as_float(a[0]) + __uint_as_float(a[1]);
    const auto b = __builtin_amdgcn_permlane32_swap(__float_as_uint(v), __float_as_uint(v), false, false); return __uint_as_float(b[0]) + __uint_as_float(b[1]);
}
__device__ __forceinline__ void row_rstd8(float (&sc)[2][4], const float* rstd, int row0, int fq) {
    (void)fq;
#pragma unroll
    for (int ai = 0; ai < 2; ++ai)
#pragma unroll
        for (int m = 0; m < 4; ++m) sc[ai][m] = rstd[row0 + ai * HALF + m * 16];
}
struct EpiBf16s {
    static constexpr bool PERM = true, AFTER_DRAIN = false, APERM = false;
    bf16_t* O; const float* rs; const float* aq; const float* ak; const float* cq; const float* ck;
    __device__ __forceinline__ void operator()(const f32x4 (&acc)[2][2][4][2], const Unit& u, int wr, int wc, int fr_, int fq_) const {
        unsigned lz_ = 0u; asm volatile("" : "+v"(lz_)); const int ln_ = __builtin_amdgcn_mbcnt_hi(~0u, __builtin_amdgcn_mbcnt_lo(~0u, lz_)); const int fr = ln_ & 15, fq = ln_ >> 4; (void)fr_; (void)fq_;
        const int row0 = u.pm * BM + wr * 64 + fr; const int slot = 4 * u.pn + wc;
        const float* gp = nullptr; float gsc = 1.0f;
        if (slot < 8) { gp = aq; gsc = 0.125f * 1.4426950408889634f; } else if (slot < 10) gp = ak; else if (slot >= 36 && slot < 52) { gp = cq; gsc = 0.125f * 1.4426950408889634f; } else if (slot >= 52 && slot < 68) gp = ck;
        f32x4 gv[2][2];
#pragma unroll
        for (int bj = 0; bj < 2; ++bj)
#pragma unroll
            for (int n = 0; n < 2; ++n) gv[bj][n] = gp ? *(const f32x4*)(gp + 32 * bj + 8 * fq + 4 * n) * gsc : (f32x4){1.f, 1.f, 1.f, 1.f};
        float scs[2][4]; row_rstd8(scs, rs, row0, fq);
#pragma unroll
        for (int ai = 0; ai < 2; ++ai)
#pragma unroll
            for (int m = 0; m < 4; ++m) { const int row = row0 + ai * HALF + m * 16; const float sc = scs[ai][m];
                f32x4 v[2][2];
#pragma unroll
                for (int bj = 0; bj < 2; ++bj)
#pragma unroll
                    for (int n = 0; n < 2; ++n) v[bj][n] = acc[ai][bj][m][n] * sc;
                if (gp) { float ss = 0.f;
#pragma unroll
                    for (int bj = 0; bj < 2; ++bj)
#pragma unroll
                        for (int n = 0; n < 2; ++n) ss += (v[bj][n][0] * v[bj][n][0] + v[bj][n][1] * v[bj][n][1]) + (v[bj][n][2] * v[bj][n][2] + v[bj][n][3] * v[bj][n][3]);
                    ss = sum_fq(ss);
                    const float f = __builtin_amdgcn_rsqf(ss * (1.0f / 64.0f) + 1e-6f);
#pragma unroll
                    for (int bj = 0; bj < 2; ++bj)
#pragma unroll
                        for (int n = 0; n < 2; ++n) v[bj][n] = v[bj][n] * (gv[bj][n] * f); }
                bf16_t* rowp = O + (((size_t)(row >> 12) * 84 + slot) * 4096 + (row & 4095)) * 64 + 8 * fq;
#pragma unroll
                for (int bj = 0; bj < 2; ++bj) { u32x4 w; w.x = cvt_pk_bf16(v[bj][0][0], v[bj][0][1]); w.y = cvt_pk_bf16(v[bj][0][2], v[bj][0][3]); w.z = cvt_pk_bf16(v[bj][1][0], v[bj][1][1]); w.w = cvt_pk_bf16(v[bj][1][2], v[bj][1][3]);
                    *(u32x4*)(rowp + 32 * bj) = w; } }
    }
};
struct EpiRes {
    static constexpr bool PERM = true, AFTER_DRAIN = false;
    const float* basef; const bf16_t* baseb; float* outf; bf16_t* outb; float* rs; int ldc;
    __device__ __forceinline__ void operator()(const f32x4 (&acc)[2][2][4][2], const Unit& u, int wr, int wc, int fr_, int fq_) const {
        unsigned lz_ = 0u; asm volatile("" : "+v"(lz_)); const int ln_ = __builtin_amdgcn_mbcnt_hi(~0u, __builtin_amdgcn_mbcnt_lo(~0u, lz_)); const int fr = ln_ & 15, fq = ln_ >> 4; (void)fr_; (void)fq_;
        const int row0 = u.pm * BM + wr * 64 + fr; const int col0 = u.pn * BM + wc * 32 + 8 * fq;
        u32x4 bw[2][2][2][2];
        if (!basef) {
#pragma unroll
            for (int ai = 0; ai < 2; ++ai)
#pragma unroll
                for (int m = 0; m < 4; ++m)
#pragma unroll
                    for (int bj = 0; bj < 2; ++bj) bw[ai][m >> 1][m & 1][bj] = *(const u32x4*)(baseb + (size_t)(row0 + ai * HALF + m * 16) * ldc + col0 + bj * HALF);
            asm volatile("" ::: "memory");
        }
#pragma unroll
        for (int ai = 0; ai < 2; ++ai)
#pragma unroll
            for (int mp = 0; mp < 2; ++mp) {
                f32x4 b[2][2][2];
#pragma unroll
                for (int mm = 0; mm < 2; ++mm) { const size_t off = (size_t)(row0 + ai * HALF + (2 * mp + mm) * 16) * ldc + col0;
#pragma unroll
                    for (int bj = 0; bj < 2; ++bj) {
                        if (basef) { b[mm][bj][0] = *(const f32x4*)(basef + off + bj * HALF); b[mm][bj][1] = *(const f32x4*)(basef + off + bj * HALF + 4); }
                        else { const u32x4 w = bw[ai][mp][mm][bj];
                            b[mm][bj][0] = (f32x4){__uint_as_float(w.x << 16), __uint_as_float(w.x & 0xffff0000u), __uint_as_float(w.y << 16), __uint_as_float(w.y & 0xffff0000u)};
                            b[mm][bj][1] = (f32x4){__uint_as_float(w.z << 16), __uint_as_float(w.z & 0xffff0000u), __uint_as_float(w.w << 16), __uint_as_float(w.w & 0xffff0000u)}; } } }
                asm volatile("" ::: "memory");
#pragma unroll
                for (int mm = 0; mm < 2; ++mm) { const int m = 2 * mp + mm, row = row0 + ai * HALF + m * 16; const size_t off = (size_t)row * ldc + col0; float ss = 0.f;
#pragma unroll
                    for (int bj = 0; bj < 2; ++bj) { const f32x4 v0 = b[mm][bj][0] + acc[ai][bj][m][0], v1 = b[mm][bj][1] + acc[ai][bj][m][1];
                        if (outf) { *(f32x4*)(outf + off + bj * HALF) = v0; *(f32x4*)(outf + off + bj * HALF + 4) = v1; }
                        else { ss += ((v0[0] * v0[0] + v0[1] * v0[1]) + (v0[2] * v0[2] + v0[3] * v0[3])) + ((v1[0] * v1[0] + v1[1] * v1[1]) + (v1[2] * v1[2] + v1[3] * v1[3]));
                            u32x4 w; w.x = cvt_pk_bf16(v0[0], v0[1]); w.y = cvt_pk_bf16(v0[2], v0[3]); w.z = cvt_pk_bf16(v1[0], v1[1]); w.w = cvt_pk_bf16(v1[2], v1[3]); *(u32x4*)(outb + off + bj * HALF) = w; } }
                    if (!outf) { ss = sum_fq(ss); if (fq == 0) rs[(size_t)row * 32 + u.pn * 4 + wc] = ss; } }
                asm volatile("" ::: "memory");
            }
    }
};
__device__ __forceinline__ float dpp_ror1(float s) { return __int_as_float(__builtin_amdgcn_mov_dpp(__float_as_int(s), 0x121, 0xf, 0xf, false)); }
__device__ __forceinline__ float dpp_ror2(float s) { return __int_as_float(__builtin_amdgcn_mov_dpp(__float_as_int(s), 0x122, 0xf, 0xf, false)); }
__device__ __forceinline__ float dpp_shr1(float old, float s) { return __int_as_float(__builtin_amdgcn_update_dpp(__float_as_int(old), __float_as_int(s), 0x111, 0xf, 0xf, false)); }
__device__ __forceinline__ float dpp_shr2(float old, float s) { return __int_as_float(__builtin_amdgcn_update_dpp(__float_as_int(old), __float_as_int(s), 0x112, 0xf, 0xf, false)); }
struct EpiConvGate {
    static constexpr bool PERM = true, AFTER_DRAIN = false;
    static constexpr int FF = 5632, UWc = 11264;
    bf16_t* act; const float* cw; const float* cb; float* uh; PG8_LAS float* xch; const float* rs;
    __device__ __forceinline__ void operator()(const f32x4 (&acc_)[2][2][4][2], const Unit& u, int wr, int wc, int fr_, int fq_) const {
        unsigned lz_ = 0u; asm volatile("" : "+v"(lz_)); const int ln_ = __builtin_amdgcn_mbcnt_hi(~0u, __builtin_amdgcn_mbcnt_lo(~0u, lz_)); const int fr = ln_ & 15, fq = ln_ >> 4; (void)fr_; (void)fq_;
        const int chl = wc * 32 + 8 * fq, ch0 = u.pn * 128 + chl;
        f32x4 (&acc)[2][2][4][2] = const_cast<f32x4 (&)[2][2][4][2]>(acc_);
        { float scs[2][4]; row_rstd8(scs, rs, u.pm * BM + wr * 64 + fr, fq);
#pragma unroll
          for (int ai = 0; ai < 2; ++ai)
#pragma unroll
              for (int m = 0; m < 4; ++m)
#pragma unroll
                  for (int bj = 0; bj < 2; ++bj)
#pragma unroll
                      for (int n = 0; n < 2; ++n) acc[ai][bj][m][n] = acc[ai][bj][m][n] * scs[ai][m]; }
        if (fr >= 14) {
#pragma unroll
            for (int ai = 0; ai < 2; ++ai)
#pragma unroll
                for (int bj = 0; bj < 2; ++bj)
#pragma unroll
                    for (int n = 0; n < 2; ++n) *(PG8_LAS f32x4*)(xch + ((2 * ai + wr) * 2 + (fr - 14)) * 256 + bj * 128 + chl + 4 * n) = acc[ai][bj][3][n];
        }
        { float* uht = uh + (size_t)u.pm * 4 * UWc + u.pn * 256 + chl;
          if (wr == 0 && fr < 2) {
#pragma unroll
              for (int bj = 0; bj < 2; ++bj)
#pragma unroll
                  for (int n = 0; n < 2; ++n) *(f32x4*)(uht + fr * UWc + bj * 128 + 4 * n) = acc[0][bj][0][n]; }
          if (wr == 1 && fr >= 14) {
#pragma unroll
              for (int bj = 0; bj < 2; ++bj)
#pragma unroll
                  for (int n = 0; n < 2; ++n) *(f32x4*)(uht + (fr - 12) * UWc + bj * 128 + 4 * n) = acc[1][bj][3][n]; } }
        asm volatile("s_waitcnt lgkmcnt(0)" ::: "memory"); __builtin_amdgcn_s_barrier(); asm volatile("" ::: "memory");
        const bool seq0 = ((u.pm * BM) & 4095) == 0;
#pragma unroll
        for (int n = 0; n < 2; ++n) {
            f32x4 wgt[3][2], bia[2];
#pragma unroll
            for (int bj = 0; bj < 2; ++bj) { bia[bj] = *(const f32x4*)(cb + bj * FF + ch0 + 4 * n);
#pragma unroll
                for (int i = 0; i < 3; ++i) wgt[i][bj] = *(const f32x4*)(cw + i * UWc + bj * FF + ch0 + 4 * n); }
#pragma unroll
            for (int ai = 0; ai < 2; ++ai) {
                const int bi = 2 * ai + wr;
                f32x4 prev[2];
#pragma unroll
                for (int bj = 0; bj < 2; ++bj) { const f32x4 v = *(const PG8_LAS f32x4*)(xch + ((bi > 0 ? bi - 1 : 0) * 2 + (fr & 1)) * 256 + bj * 128 + chl + 4 * n);
                    prev[bj] = bi > 0 ? v : (f32x4){0.f, 0.f, 0.f, 0.f}; }
#pragma unroll
                for (int m = 0; m < 4; ++m) {
                    float o[4];
#pragma unroll
                    for (int e = 0; e < 4; ++e) {
                        const float gc = acc[ai][0][m][n][e], gp = prev[0][e]; const float g1 = dpp_shr1(dpp_ror1(gp), gc), g2 = dpp_shr2(dpp_ror2(gp), gc);
                        const float uc = acc[ai][1][m][n][e], up = prev[1][e]; const float u1 = dpp_shr1(dpp_ror1(up), uc), u2 = dpp_shr2(dpp_ror2(up), uc);
                        const float gv = bia[0][e] + wgt[0][0][e] * g2 + wgt[1][0][e] * g1 + wgt[2][0][e] * gc;
                        const float uv = bia[1][e] + wgt[0][1][e] * u2 + wgt[1][1][e] * u1 + wgt[2][1][e] * uc;
                        o[e] = gv * __builtin_amdgcn_rcpf(1.0f + __builtin_amdgcn_exp2f(-1.4426950408889634f * gv)) * uv; }
                    prev[0] = acc[ai][0][m][n]; prev[1] = acc[ai][1][m][n];
                    const int row = u.pm * BM + ai * HALF + wr * 64 + m * 16 + fr;
                    if (!(bi == 0 && m == 0 && fr < 2 && !seq0)) { u32x2 w; w.x = cvt_pk_bf16(o[0], o[1]); w.y = cvt_pk_bf16(o[2], o[3]); *(u32x2*)(act + (size_t)row * FF + ch0 + 4 * n) = w; }
                }
            }
        }
    }
};
template <class Epi, class Sched, bool ALIGN_EPI = false, bool SP2 = false>
__device__ __forceinline__ void gemm_phase(PG8_LAS unsigned char* lds, const Gemm g, const Sched& S, const Epi& E, int tid_in) {
    int tid_o = tid_in; asm volatile("" : "+v"(tid_o));
    const int tid = tid_o, wid = __builtin_amdgcn_readfirstlane(tid >> 6), lane = tid & 63, wr = wid >> 2, wc = wid & 3, fr = lane & 15, fq = lane >> 4;
    const int K = g.K, nt = K / BK;
    unsigned voffA[2], voffB[2];
#pragma unroll
    for (int i = 0; i < 2; ++i) { int R, C; stage_rc(tid * 16 + i * 8192, R, C); const int Rb = Epi::PERM ? ((R & ~31) + perm32(R & 31)) : R;
        voffA[i] = (unsigned)(R * K + C) * 2u; voffB[i] = (unsigned)(Rb * K + C) * 2u; }
    const size_t kstep = (size_t)(BK * 2);
    const size_t hstep = (size_t)HALF * K * 2;
    const size_t tstep = 2 * hstep;
    const unsigned ldsw = (unsigned)wid * 1024u;
    const int aoff = lds_byte(wr * 64 + fr, fq * 8), boff = lds_byte(wc * 32 + fr, fq * 8);
#define PG8_SA(b, h) (((b) * 2 + (h)) * HTB)
#define PG8_SB(b, h) ((4 + (b) * 2 + (h)) * HTB)
#define PG8_STAGE(bufoff, gbase, voff) do { _Pragma("unroll") for (int _i = 0; _i < 2; ++_i) \
        __builtin_amdgcn_global_load_lds((const unsigned*)((const char*)(gbase) + (voff)[_i]), (PG8_LAS unsigned*)(lds + (bufoff) + ldsw + _i * 8192), 16, 0, 0); } while (0)
#define PG8_LDA(dst, b, h) do { _Pragma("unroll") for (int m = 0; m < 4; ++m) _Pragma("unroll") for (int k = 0; k < 2; ++k) dst[m][k] = *(const PG8_LAS bf16x8*)(lds + PG8_SA(b, h) + aoff + m * 2048 + k * 1024); } while (0)
#define PG8_LDB(dst, b, h) do { _Pragma("unroll") for (int n = 0; n < 2; ++n) _Pragma("unroll") for (int k = 0; k < 2; ++k) dst[n][k] = *(const PG8_LAS bf16x8*)(lds + PG8_SB(b, h) + boff + n * 2048 + k * 1024); } while (0)
#define PG8_MMA(ai, bj, At, Bt) do { __builtin_amdgcn_s_setprio(1); _Pragma("unroll") for (int m = 0; m < 4; ++m) _Pragma("unroll") for (int n = 0; n < 2; ++n) _Pragma("unroll") for (int k = 0; k < 2; ++k) \
        acc[ai][bj][m][n] = __builtin_amdgcn_mfma_f32_16x16x32_bf16(Bt[n][k], At[m][k], acc[ai][bj][m][n], 0, 0, 0); __builtin_amdgcn_s_setprio(0); } while (0)
#define PG8_WAIT_V(n) asm volatile("s_waitcnt vmcnt(" #n ")" ::: "memory")
#define PG8_WAIT_L(n) asm volatile("s_waitcnt lgkmcnt(" #n ")" ::: "memory")
#define PG8_BAR __builtin_amdgcn_s_barrier()
#define PG8_SCHED __builtin_amdgcn_sched_barrier(0)
    Unit cur, nxt; int ui = 0;
    if (!S.next(0, cur)) return;
    f32x4 acc[2][2][4][2];
#pragma unroll
    for (int a = 0; a < 2; ++a)
#pragma unroll
        for (int b = 0; b < 2; ++b)
#pragma unroll
            for (int m = 0; m < 4; ++m)
#pragma unroll
                for (int n = 0; n < 2; ++n) acc[a][b][m][n] = (f32x4){0.f, 0.f, 0.f, 0.f};
    bf16x8 At[4][2], B0[2][2], B1[2][2];
    const char* cA = (const char*)g.A + (size_t)cur.pm * tstep; const char* cB = (const char*)g.Bt + (size_t)cur.pn * tstep;
    S.a_ready(cur);
    if constexpr (SP2) {
        PG8_STAGE(PG8_SB(0, 0), cB, voffB); PG8_STAGE(PG8_SB(0, 1), cB + hstep, voffB); PG8_STAGE(PG8_SA(0, 0), cA, voffA); PG8_STAGE(PG8_SA(0, 1), cA + hstep, voffA);
        if (wr == 1) PG8_BAR;
        PG8_WAIT_V(2); PG8_BAR;
        PG8_STAGE(PG8_SB(1, 0), cB + kstep, voffB); PG8_STAGE(PG8_SA(1, 0), cA + kstep, voffA); PG8_STAGE(PG8_SB(1, 1), cB + hstep + kstep, voffB);
        PG8_WAIT_V(6); PG8_BAR;
    } else {
        PG8_STAGE(PG8_SB(0, 0), cB, voffB); PG8_STAGE(PG8_SA(0, 0), cA, voffA); PG8_STAGE(PG8_SB(0, 1), cB + hstep, voffB); PG8_STAGE(PG8_SA(0, 1), cA + hstep, voffA);
        if (wr == 1) PG8_BAR;
        PG8_WAIT_V(4); PG8_BAR;
        PG8_STAGE(PG8_SB(1, 0), cB + kstep, voffB); PG8_STAGE(PG8_SA(1, 0), cA + kstep, voffA); PG8_STAGE(PG8_SB(1, 1), cB + hstep + kstep, voffB);
        PG8_WAIT_V(6); PG8_BAR;
    }
    for (;;) {
        const bool has_next = S.next(ui + 1, nxt);
        const char* nA = has_next ? (const char*)g.A + (size_t)nxt.pm * tstep : cA; const char* nB = has_next ? (const char*)g.Bt + (size_t)nxt.pn * tstep : cB;
        for (int t = 0; t < nt; t += 2) {
            const bool last = (t == nt - 2);
            const char* a1 = cA + (size_t)(t + 1) * kstep;
            const char* a2 = last ? nA : cA + (size_t)(t + 2) * kstep; const char* b2 = last ? nB : cB + (size_t)(t + 2) * kstep;
            const char* a3 = a2 + kstep; const char* b3 = b2 + kstep;
            if (last && has_next) S.a_ready(nxt);
            if constexpr (SP2) {
            PG8_LDB(B0, 0, 0); PG8_LDB(B1, 0, 1); PG8_SCHED; PG8_LDA(At, 0, 0); PG8_STAGE(PG8_SA(1, 1), a1 + hstep, voffA);
            PG8_WAIT_V(8); PG8_WAIT_L(0); PG8_BAR; PG8_MMA(0, 0, At, B0); PG8_MMA(0, 1, At, B1); PG8_BAR; PG8_SCHED;
            PG8_LDA(At, 0, 1); PG8_STAGE(PG8_SB(0, 0), b2, voffB); PG8_STAGE(PG8_SB(0, 1), b2 + hstep, voffB); PG8_STAGE(PG8_SA(0, 0), a2, voffA);
            PG8_WAIT_V(8); PG8_WAIT_L(0); PG8_BAR; PG8_MMA(1, 0, At, B0); PG8_MMA(1, 1, At, B1); PG8_BAR; PG8_SCHED;
            PG8_LDB(B0, 1, 0); PG8_LDB(B1, 1, 1); PG8_SCHED; PG8_LDA(At, 1, 0); PG8_STAGE(PG8_SA(0, 1), a2 + hstep, voffA);
            PG8_WAIT_V(8); PG8_WAIT_L(0); PG8_BAR; PG8_MMA(0, 0, At, B0); PG8_MMA(0, 1, At, B1); PG8_BAR; PG8_SCHED;
            PG8_LDA(At, 1, 1); PG8_STAGE(PG8_SB(1, 0), b3, voffB); PG8_STAGE(PG8_SB(1, 1), b3 + hstep, voffB); PG8_STAGE(PG8_SA(1, 0), a3, voffA);
            PG8_WAIT_V(8); PG8_WAIT_L(0); PG8_BAR; PG8_MMA(1, 0, At, B0); PG8_MMA(1, 1, At, B1); PG8_BAR; PG8_SCHED;
            } else {
            PG8_LDB(B0, 0, 0); PG8_SCHED; PG8_LDA(At, 0, 0); PG8_STAGE(PG8_SA(1, 1), a1 + hstep, voffA);
            PG8_WAIT_L(8); PG8_BAR; PG8_WAIT_L(0); PG8_MMA(0, 0, At, B0); PG8_BAR; PG8_SCHED;
            PG8_LDB(B1, 0, 1); PG8_STAGE(PG8_SB(0, 0), b2, voffB);
            PG8_BAR; PG8_WAIT_L(0); PG8_MMA(0, 1, At, B1); PG8_BAR;
            PG8_LDA(At, 0, 1); PG8_STAGE(PG8_SA(0, 0), a2, voffA);
            PG8_BAR; PG8_WAIT_L(0); PG8_MMA(1, 0, At, B0); PG8_BAR; PG8_SCHED;
            PG8_STAGE(PG8_SB(0, 1), b2 + hstep, voffB);
            PG8_WAIT_V(6); PG8_BAR; PG8_MMA(1, 1, At, B1); PG8_BAR;
            PG8_LDB(B0, 1, 0); PG8_SCHED; PG8_LDA(At, 1, 0); PG8_STAGE(PG8_SA(0, 1), a2 + hstep, voffA);
            PG8_WAIT_L(8); PG8_BAR; PG8_WAIT_L(0); PG8_MMA(0, 0, At, B0); PG8_BAR; PG8_SCHED;
            PG8_LDB(B1, 1, 1); PG8_STAGE(PG8_SB(1, 0), b3, voffB);
            PG8_BAR; PG8_WAIT_L(0); PG8_MMA(0, 1, At, B1); PG8_BAR;
            PG8_LDA(At, 1, 1); PG8_STAGE(PG8_SA(1, 0), a3, voffA);
            PG8_BAR; PG8_WAIT_L(0); PG8_MMA(1, 0, At, B0); PG8_BAR; PG8_SCHED;
            PG8_STAGE(PG8_SB(1, 1), b3 + hstep, voffB);
            PG8_WAIT_V(6); PG8_BAR; PG8_MMA(1, 1, At, B1); PG8_BAR;
            }
        }
        if constexpr (ALIGN_EPI) { if (wr == 0) PG8_BAR; }
        if constexpr (!Epi::AFTER_DRAIN) { E(acc, cur, wr, wc, fr, fq); S.done(cur); }
        if (!has_next) break;
#pragma unroll
        for (int a = 0; a < 2; ++a)
#pragma unroll
            for (int b = 0; b < 2; ++b)
#pragma unroll
                for (int m = 0; m < 4; ++m)
#pragma unroll
                    for (int n = 0; n < 2; ++n) acc[a][b][m][n] = (f32x4){0.f, 0.f, 0.f, 0.f};
        cur = nxt; cA = nA; cB = nB; ++ui;
        if constexpr (ALIGN_EPI) { if (wr == 1) PG8_BAR; }
    }
    PG8_WAIT_V(0);
    if constexpr (!ALIGN_EPI) { if (wr == 0) PG8_BAR; }
    PG8_BAR;
    if constexpr (Epi::AFTER_DRAIN) { E.fused(acc, cur, wr, wc, fr, fq, lds, wid, lane); S.done(cur); }
#undef PG8_SA
#undef PG8_SB
#undef PG8_STAGE
#undef PG8_LDA
#undef PG8_LDB
#undef PG8_MMA
#undef PG8_WAIT_V
#undef PG8_WAIT_L
#undef PG8_BAR
#undef PG8_SCHED
}
}
constexpr int NB = 8, SEQ = 4096, DM = 2048, DEPTH = 4, MTOK = NB * SEQ;
constexpr int PW = 5376, DFF = 5632, UW = 2 * DFF, ATW = 4096, NBUCK = 32;
constexpr int PC_AQ = 0, PC_AK = 512, PC_AV = 640, PC_BQ = 768, PC_BK = 1280, PC_BV = 1792, PC_CQ = 2304, PC_CK = 3328, PC_CV = 4352;
constexpr int AT_A = 0, AT_B = 512, AT_C = 1024;
constexpr float EPS = 1e-6f;
constexpr size_t MiB = 1u << 20;
constexpr size_t WS_R1_ = 456 * MiB;
constexpr size_t WS_WIN = 0, WS_WOUT = 21 * MiB, WS_WUP = 29 * MiB, WS_WDOWN = 73 * MiB, WS_LSE = 96 * MiB;
constexpr size_t WS_BIAS = 102 * MiB, WS_GQK = 102 * MiB + 65536;
constexpr size_t WS_XB2 = WS_R1_ + 352 * MiB;
constexpr size_t WS_MIX = 104 * MiB + 128 * MiB;
constexpr size_t WS_CTL = 103 * MiB;
constexpr size_t WS_R2 = 104 * MiB;
constexpr size_t WS_R1 = 456 * MiB;
constexpr size_t WS_ATT = WS_R1 + 336 * MiB;
constexpr size_t WS_UH = WS_R1 + 704 * MiB;
constexpr size_t WS_RS1 = WS_UH + 24 * MiB, WS_RS2 = WS_RS1 + 4 * MiB;
constexpr size_t WS_RSTD1 = WS_RS2 + 4 * MiB, WS_RSTD2 = WS_RSTD1 + 131072;
constexpr size_t WS_END = WS_RSTD1 + 1 * MiB;
constexpr int LDS_XCH = 131072 + 64;
constexpr int LDS_BYTES = 131072 + 64 + 8192;
constexpr int NWAVES = 8;

#define GAS __attribute__((address_space(1)))
#define LAS __attribute__((address_space(3)))
typedef unsigned short bf16;
typedef unsigned v4u __attribute__((ext_vector_type(4)));
typedef float f32x4 __attribute__((ext_vector_type(4)));
#define LDS_WAIT() asm volatile("s_waitcnt lgkmcnt(0)" ::: "memory")
__device__ __forceinline__ unsigned f2bf(float f) { unsigned u = __builtin_bit_cast(unsigned, f); return (u + 0x7fffu + ((u >> 16) & 1u)) >> 16; }
typedef float f32x2_t __attribute__((ext_vector_type(2))); typedef __bf16 bf16x2_t __attribute__((ext_vector_type(2)));
__device__ __forceinline__ unsigned pk2(float lo, float hi) { const f32x2_t v = {lo, hi}; const bf16x2_t b = __builtin_convertvector(v, bf16x2_t); return __builtin_bit_cast(unsigned, b); }
__device__ __forceinline__ float bflo(unsigned w) { return __uint_as_float(w << 16); }
__device__ __forceinline__ float bfhi(unsigned w) { return __uint_as_float(w & 0xffff0000u); }
__device__ __forceinline__ float wave_sum(float v) {
#pragma unroll
    for (int o = 1; o < 64; o <<= 1) v += __shfl_xor(v, o);
    return v;
}
#define DPP_F(v, CTRL) __int_as_float(__builtin_amdgcn_mov_dpp(__float_as_int(v), (CTRL), 0xf, 0xf, false))
__device__ __forceinline__ float red8_dpp(float v) { v += DPP_F(v, 0xB1); v += DPP_F(v, 0x4E); v += DPP_F(v, 0x141); return v; }
__device__ __forceinline__ float sum_halves(float v) { const auto rr = __builtin_amdgcn_permlane32_swap(__float_as_uint(v), __float_as_uint(v), false, false); return __uint_as_float(rr[0]) + __uint_as_float(rr[1]); }
#define UNPACK8(wv_, f) do { const v4u w_ = (wv_); f[0] = bflo(w_.x); f[1] = bfhi(w_.x); f[2] = bflo(w_.y); f[3] = bfhi(w_.y); f[4] = bflo(w_.z); f[5] = bfhi(w_.z); f[6] = bflo(w_.w); f[7] = bfhi(w_.w); } while (0)

#define RLX_AGENT __ATOMIC_RELAXED, __HIP_MEMORY_SCOPE_AGENT
#define XB_TMO      128
#define XB_XCNT(j)  (256  + 64 * (j))
#define XB_XSUB(j)  (1280 + 64 * (j))
#define XB_XGEN(j)  (2304 + 64 * (j))
#define XB_TOP      3328
#define XB_TOPGEN   3392
#define XCD_BAR_WORDS 3456
#define XB_SPIN_CAP (1u << 18)

__device__ __forceinline__ unsigned xb_ld(unsigned* p)              { return __hip_atomic_load(p, __ATOMIC_RELAXED, __HIP_MEMORY_SCOPE_AGENT); }
__device__ __forceinline__ unsigned xb_add(unsigned* p, unsigned v) { return __hip_atomic_fetch_add(p, v, __ATOMIC_RELAXED, __HIP_MEMORY_SCOPE_AGENT); }
__device__ __forceinline__ unsigned xb_xcc_id() { return (unsigned)__builtin_amdgcn_s_getreg((3 << 11) | 20) & 0xFu; }
#define XB_SPIN(cond, bar) do { unsigned _sp = 0; while (cond) { __builtin_amdgcn_s_sleep(1); \
    if ((++_sp & 255u) == 0u) { if (xb_ld(&(bar)[XB_TMO])) break; if (_sp > XB_SPIN_CAP) { atomicAdd(&(bar)[XB_TMO], 1u); break; } } } } while (0)

struct XcdBarrier {
    unsigned* bar; unsigned x;
    volatile LAS unsigned* st;
};

__device__ __forceinline__ XcdBarrier xcd_barrier_post(unsigned* bar, volatile LAS unsigned* st) {
    XcdBarrier b; b.bar = bar; b.x = xb_xcc_id(); b.st = st;
    if (threadIdx.x == 0) (void)xb_add(&bar[XB_XCNT(b.x)], 1u);
    return b;
}
__device__ __forceinline__ void xcd_barrier_complete(unsigned* bar, unsigned x, unsigned& nloc, unsigned& nx) {
    const unsigned G = gridDim.x * gridDim.y * gridDim.z;
    unsigned sum, cnt, mine, sp = 0u;
    for (;;) {
        sum = 0u; cnt = 0u; mine = 0u;
#pragma unroll
        for (unsigned j = 0; j < 16; ++j) { const unsigned c = xb_ld(&bar[XB_XCNT(j)]); sum += c; cnt += (c > 0u) ? 1u : 0u; mine = (j == x) ? c : mine; }
        if (sum == G) break;
        __builtin_amdgcn_s_sleep(1);
        if ((++sp & 255u) == 0u) { if (xb_ld(&bar[XB_TMO])) break; if (sp > XB_SPIN_CAP) { atomicAdd(&bar[XB_TMO], 1u); break; } }
    }
    nloc = mine > 0u ? mine : 1u; nx = cnt > 0u ? cnt : 1u;
}

__device__ __forceinline__ void xcd_barrier(const XcdBarrier& b, int wave_) {
    unsigned lzb_ = 0u; asm volatile("" : "+v"(lzb_)); const bool leader_ = (wave_ == 0) && (__builtin_amdgcn_mbcnt_hi(~0u, __builtin_amdgcn_mbcnt_lo(~0u, lzb_)) == 0u);
    asm volatile("s_waitcnt vmcnt(0)" ::: "memory");
    __syncthreads();
    if (leader_) {
        unsigned* bar = b.bar;
        __builtin_amdgcn_s_waitcnt(0);
        unsigned nloc = b.st[0], nx = b.st[1];
        if (nloc == 0u) { xcd_barrier_complete(bar, b.x, nloc, nx); b.st[0] = nloc; b.st[1] = nx; }
        const unsigned old = xb_add(&bar[XB_XSUB(b.x)], 1u);
        const unsigned gen = old / nloc;
        if (old + 1u == (gen + 1u) * nloc) {
            __builtin_amdgcn_fence(__ATOMIC_RELEASE, "agent");
            asm volatile("s_waitcnt vmcnt(0)" ::: "memory");
            const unsigned og = xb_add(&bar[XB_TOP], 1u);
            const unsigned tg = og / nx;
            if (og + 1u == (tg + 1u) * nx) xb_add(&bar[XB_TOPGEN], 1u);
            else XB_SPIN(xb_ld(&bar[XB_TOPGEN]) == tg, bar);
            __builtin_amdgcn_fence(__ATOMIC_ACQUIRE, "agent");
            xb_add(&bar[XB_XGEN(b.x)], 1u);
            asm volatile("s_waitcnt vmcnt(0)" ::: "memory");
        } else {
            XB_SPIN(xb_ld(&bar[XB_XGEN(b.x)]) == gen, bar);
            __builtin_amdgcn_fence(__ATOMIC_ACQUIRE, "agent");
            asm volatile("s_waitcnt vmcnt(0)" ::: "memory");
        }
    }
    __syncthreads();
}
typedef short bf16x8 __attribute__((ext_vector_type(8)));
typedef short s16x4 __attribute__((ext_vector_type(4)));
typedef float f32x16 __attribute__((ext_vector_type(16)));
typedef unsigned u32x2v __attribute__((ext_vector_type(2)));
#define MFMA32(a, b, c) __builtin_amdgcn_mfma_f32_32x32x16_bf16((a), (b), (c), 0, 0, 0)
constexpr int KP = 144;
constexpr float LOG2E = 1.4426950408889634f, LN2 = 0.6931471805599453f;
typedef __bf16 bf16x2_dt __attribute__((ext_vector_type(2)));
__device__ __forceinline__ float sumsq8(const v4u& w, float acc) {
    float f[8]; UNPACK8(w, f);
#pragma unroll
    for (int e = 0; e < 8; ++e) acc += f[e] * f[e];
    return acc;
}
__device__ __forceinline__ int kvperm(int rho) { return 16 * ((rho >> 2) & 1) + (rho & 3) + 4 * (rho >> 3); }
__device__ __forceinline__ s16x4 trrd(const LAS unsigned char* p) { typedef short v4i16_t __attribute__((ext_vector_type(4))); return __builtin_bit_cast(s16x4, __builtin_amdgcn_ds_read_tr16_b64_v4i16((LAS v4i16_t*)p)); }
__device__ __forceinline__ bf16x8 vfrag(const LAS unsigned char* p) { const s16x4 lo = trrd(p), hi = trrd(p + 4 * KP); return (bf16x8){lo[0], lo[1], lo[2], lo[3], hi[0], hi[1], hi[2], hi[3]}; }
__device__ __forceinline__ bf16x8 pack8(const f32x16& x, int s) {
    v4u p; p.x = pk2(x[8 * s], x[8 * s + 1]); p.y = pk2(x[8 * s + 2], x[8 * s + 3]); p.z = pk2(x[8 * s + 4], x[8 * s + 5]); p.w = pk2(x[8 * s + 6], x[8 * s + 7]);
    return __builtin_bit_cast(bf16x8, p);
}
__device__ __forceinline__ void store_ot(bf16* orow, const f32x16 (&o)[2], float sc, int h) {
#pragma unroll
    for (int db = 0; db < 2; ++db)
#pragma unroll
        for (int p = 0; p < 2; ++p) { const int g0 = 2 * p, g1 = 2 * p + 1;
            const unsigned a0 = pk2(o[db][4 * g0] * sc, o[db][4 * g0 + 1] * sc), a1 = pk2(o[db][4 * g0 + 2] * sc, o[db][4 * g0 + 3] * sc);
            const unsigned b0 = pk2(o[db][4 * g1] * sc, o[db][4 * g1 + 1] * sc), b1 = pk2(o[db][4 * g1 + 2] * sc, o[db][4 * g1 + 3] * sc);
            const auto rx = __builtin_amdgcn_permlane32_swap(a0, b0, false, false), ry = __builtin_amdgcn_permlane32_swap(a1, b1, false, false);
            v4u w; w.x = rx[0]; w.y = ry[0]; w.z = rx[1]; w.w = ry[1];
            *(v4u*)(orow + 32 * db + 16 * p + 8 * h) = w; }
}
struct BandCfg { const bf16* qg; const bf16* kg; const bf16* vg; size_t rstride; int q0; int maxd; const float* bias2; int gqk; float sink2; bf16* og; size_t ostride; float* lseg; size_t lstride; };
__device__ __forceinline__ BandCfg band_cfg(int u, const bf16* PROJ, bf16* ATT, float* LSE, const float* B2, const float* GQ, const float* a_sinks) {
    BandCfg c;
    if (u < 2048) { const int v = u - 1024, b = 7 - (v >> 7), hh = (v >> 4) & 7, qb = v & 15;     const bf16* pb = PROJ + (size_t)b * 84 * SEQ * 64;
        c.qg = pb + (size_t)hh * SEQ * 64; c.kg = pb + (size_t)(8 + (hh >> 2)) * SEQ * 64; c.vg = pb + (size_t)(10 + (hh >> 2)) * SEQ * 64; c.rstride = 64; c.q0 = qb * 256; c.maxd = 127;
        c.bias2 = B2 + hh * 160; c.gqk = 0; c.sink2 = a_sinks[hh] * LOG2E; c.og = ATT + ((size_t)b * 64 + hh) * SEQ * 64; c.ostride = 64; c.lseg = nullptr; c.lstride = 0; }
    else { const int v = u - 2048, g = v / 48, rem = v - 48 * g, br = rem >> 4, k = rem & 15, b = 7 - (g >> 4), hh = g & 15;     const int dil = 1 << (2 * br), sub = k & (dil - 1), blk = k >> (2 * br);
        const bf16* pb = PROJ + ((size_t)b * 84 * SEQ + sub) * 64;
        c.qg = pb + (size_t)(36 + hh) * SEQ * 64; c.kg = pb + (size_t)(52 + hh) * SEQ * 64; c.vg = pb + (size_t)(68 + hh) * SEQ * 64; c.rstride = (size_t)dil * 64; c.q0 = blk * 256; c.maxd = 128;
        c.bias2 = B2 + ((1 + br) * 16 + hh) * 160; c.gqk = 64; c.sink2 = -1e30f; c.og = ATT + (((size_t)b * 64 + 16 + 16 * br + hh) * SEQ + sub) * 64; c.ostride = (size_t)dil * 64;
        c.lseg = LSE + ((size_t)br * MTOK + (size_t)b * SEQ + sub) * 16 + hh; c.lstride = (size_t)dil * 16; }
    return c;
}
__device__ __forceinline__ void band_fetch(const BandCfg& c, int tid, v4u (&kr)[6], v4u (&vr)[6], float& bv, v4u (&qw)[4]) {
    { const int ln = tid & 63, wv = tid >> 6, qpos = c.q0 + 32 * wv + (ln & 31);
#pragma unroll
      for (int ds = 0; ds < 4; ++ds) qw[ds] = *(const v4u*)(c.qg + (size_t)qpos * c.rstride + 16 * ds + 8 * (ln >> 5)); }
#pragma unroll
    for (int p = 0; p < 6; ++p) { const int row = p * 64 + (tid >> 3), cc = tid & 7, pos = c.q0 - 128 + row;
        kr[p] = (v4u){0u, 0u, 0u, 0u}; vr[p] = (v4u){0u, 0u, 0u, 0u};
        if (pos >= 0) { kr[p] = *(const v4u*)(c.kg + (size_t)pos * c.rstride + 8 * cc); vr[p] = *(const v4u*)(c.vg + (size_t)pos * c.rstride + 8 * cc); } }
    bv = 0.f; if (tid < 192) { const int j = 159 - tid; if (j >= 0) bv = c.bias2[j]; }
}
__device__ __forceinline__ void banded_unit(LAS unsigned char* lds, const BandCfg& c, int tid_, int lane_, int wave, v4u (&kr)[6], v4u (&vr)[6], float& bv, v4u (&qw)[4], const LAS float* gqkL, bool has_next, int un, BandCfg& cn, const bf16* PROJ, bf16* ATT, float* LSE, const float* B2, const float* a_sinks) {
    int lane = lane_; asm volatile("" : "+v"(lane)); const int tid = wave * 64 + lane; (void)tid_;
    LAS unsigned char* Kl = lds; LAS unsigned char* Vl = lds + 384 * KP; LAS float* rkL = (LAS float*)(lds + 2 * 384 * KP); LAS float* revL = rkL + 384;
    const int q0 = c.q0;
    __syncthreads();
#pragma unroll
    for (int p = 0; p < 6; ++p) { const int row = p * 64 + (tid >> 3), cc = tid & 7;
        *(LAS v4u*)(Kl + row * KP + 16 * cc) = kr[p]; *(LAS v4u*)(Vl + row * KP + 16 * cc) = vr[p]; }
    if (tid < 192) revL[tid] = bv;
    const int r = lane & 31, h = lane >> 5, qpos = q0 + 32 * wave + r;
    bf16x8 qf[4];
#pragma unroll
    for (int ds = 0; ds < 4; ++ds) qf[ds] = __builtin_bit_cast(bf16x8, qw[ds]);
    __syncthreads();
    if (has_next) { cn = band_cfg(un, PROJ, ATT, LSE, B2, nullptr, a_sinks); band_fetch(cn, tid, kr, vr, bv, qw); }
    f32x16 S[5];
#define SCHED_FENCE() __builtin_amdgcn_sched_barrier(0)
    {
        const LAS unsigned char* ka = Kl + (32 * wave + kvperm(r)) * KP + 16 * h;
        bf16x8 kf[2][4];
#pragma unroll
        for (int ds = 0; ds < 4; ++ds) kf[0][ds] = *(const LAS bf16x8*)(ka + ds * 32);
#pragma unroll
        for (int T = 0; T < 5; ++T) {
            if (T < 4) {
#pragma unroll
                for (int ds = 0; ds < 4; ++ds) kf[(T + 1) & 1][ds] = *(const LAS bf16x8*)(ka + (T + 1) * 32 * KP + ds * 32); }
            SCHED_FENCE();
            f32x16 acc;
#pragma unroll
            for (int i = 0; i < 16; ++i) acc[i] = 0.f;
            __builtin_amdgcn_s_setprio(1);
#pragma unroll
            for (int ds = 0; ds < 4; ++ds) acc = MFMA32(kf[T & 1][ds], qf[ds], acc);
            __builtin_amdgcn_s_setprio(0);
            S[T] = acc;
            SCHED_FENCE();
        }
    }
    float l = 0.f;
    {
        const int kbase = q0 + 32 * wave - 128, brel = 128 + r - 16 * h;
        int lo = brel - c.maxd; { const int l2 = -kbase - 16 * h; lo = lo > l2 ? lo : l2; }
        const unsigned span = (unsigned)(brel - lo); const int nlo = -lo;
        const LAS float* bp = revL + (159 - brel);
        float bb[1][16];
#define BAND_LOAD(T, B) _Pragma("unroll") for (int i = 0; i < 16; ++i) bb[B][i] = bp[32 * (T) + i];
#define BAND_TILE_MASKED(T, B) _Pragma("unroll") for (int i = 0; i < 16; ++i) { const int x = 32 * (T) + i; const bool ok = (unsigned)(x + nlo) <= span; \
                const float sv = S[T][i] + bb[B][i]; const float p = __builtin_amdgcn_exp2f(ok ? sv : -1e30f); S[T][i] = p; l += p; }
#define BAND_TILE_FREE(T, B) _Pragma("unroll") for (int i = 0; i < 16; ++i) { const float p = __builtin_amdgcn_exp2f(S[T][i] + bb[B][i]); S[T][i] = p; l += p; }
        if (kbase >= 0) {
            BAND_LOAD(0, 0) SCHED_FENCE(); BAND_TILE_MASKED(0, 0) SCHED_FENCE();
            BAND_LOAD(1, 0) SCHED_FENCE(); BAND_TILE_FREE(1, 0) SCHED_FENCE();
            BAND_LOAD(2, 0) SCHED_FENCE(); BAND_TILE_FREE(2, 0) SCHED_FENCE();
            BAND_LOAD(3, 0) SCHED_FENCE(); BAND_TILE_FREE(3, 0) SCHED_FENCE();
            BAND_LOAD(4, 0) SCHED_FENCE(); BAND_TILE_MASKED(4, 0)
        } else {
            BAND_LOAD(0, 0) SCHED_FENCE(); BAND_TILE_MASKED(0, 0) SCHED_FENCE();
            BAND_LOAD(1, 0) SCHED_FENCE(); BAND_TILE_MASKED(1, 0) SCHED_FENCE();
            BAND_LOAD(2, 0) SCHED_FENCE(); BAND_TILE_MASKED(2, 0) SCHED_FENCE();
            BAND_LOAD(3, 0) SCHED_FENCE(); BAND_TILE_MASKED(3, 0) SCHED_FENCE();
            BAND_LOAD(4, 0) SCHED_FENCE(); BAND_TILE_MASKED(4, 0)
        }
#undef BAND_LOAD
#undef BAND_TILE_MASKED
#undef BAND_TILE_FREE
    }
    l = sum_halves(l); l += __builtin_amdgcn_exp2f(c.sink2);
    const float m = 0.f;
    f32x16 o[2];
#pragma unroll
    for (int i = 0; i < 16; ++i) { o[0][i] = 0.f; o[1][i] = 0.f; }
    {
        const LAS unsigned char* va = Vl + (32 * wave + 16 * h + ((lane & 15) >> 2)) * KP + ((lane >> 4) & 1) * 32 + (lane & 3) * 8;
        bf16x8 vf[2][2];
        vf[0][0] = vfrag(va); vf[0][1] = vfrag(va + 64);
#pragma unroll
        for (int j = 0; j < 10; ++j) { const int T = j >> 1, sx = j & 1;
            if (j < 9) { const int Tn = (j + 1) >> 1, sn = (j + 1) & 1; vf[(j + 1) & 1][0] = vfrag(va + (32 * Tn + 8 * sn) * KP); vf[(j + 1) & 1][1] = vfrag(va + (32 * Tn + 8 * sn) * KP + 64); }
            SCHED_FENCE();
            const bf16x8 pf = pack8(S[T], sx);
            __builtin_amdgcn_s_setprio(1); o[0] = MFMA32(vf[j & 1][0], pf, o[0]); o[1] = MFMA32(vf[j & 1][1], pf, o[1]); __builtin_amdgcn_s_setprio(0);
            SCHED_FENCE();
        }
    }
#undef SCHED_FENCE
    store_ot(c.og + (size_t)qpos * c.ostride, o, __builtin_amdgcn_rcpf(l), h);
    if (c.lseg && h == 0) c.lseg[(size_t)qpos * c.lstride] = (m + __builtin_amdgcn_logf(l)) * LN2;
}
__device__ __forceinline__ void sb_tile(const LAS unsigned char* kat, const LAS unsigned char* vat, bool diag, int r, int h, const bf16x8 (&qf)[4], float& R, f32x16 (&o)[2]) {
    f32x16 z;
#pragma unroll
    for (int i = 0; i < 16; ++i) z[i] = 0.f;
    bf16x8 kf[4], vfr[2][2];
#pragma unroll
    for (int ds = 0; ds < 4; ++ds) kf[ds] = *(const LAS bf16x8*)(kat + ds * 32);
#pragma unroll
    for (int s = 0; s < 2; ++s)
#pragma unroll
        for (int db = 0; db < 2; ++db) vfr[s][db] = vfrag(vat + (8 * s) * KP + db * 64);
    __builtin_amdgcn_sched_barrier(0);
#pragma unroll
    for (int ds = 0; ds < 4; ++ds) z = MFMA32(kf[ds], qf[ds], z);
    float cs[17]; float run = 1.f; cs[16] = 1.f;
#pragma unroll
    for (int i = 15; i >= 0; --i) { const bool ok = !diag || (16 * h + i < r);
        const float e = __builtin_amdgcn_exp2f(fminf(z[i] * LOG2E, 80.0f)); const float rm = __builtin_amdgcn_rcpf(1.0f + e);
        z[i] = ok ? e * rm : 0.f; run *= ok ? rm : 1.0f; cs[i] = run; }
    float tot_o; { const auto rr = __builtin_amdgcn_permlane32_swap(__float_as_uint(run), __float_as_uint(run), false, false); tot_o = __uint_as_float(h == 0 ? rr[1] : rr[0]); }
    const float base = R * (h == 0 ? tot_o : 1.0f);
#pragma unroll
    for (int i = 0; i < 16; ++i) z[i] = z[i] * (base * cs[i + 1]);
    R *= run * tot_o;
#pragma unroll
    for (int s = 0; s < 2; ++s) { const bf16x8 pf = pack8(z, s);
#pragma unroll
        for (int db = 0; db < 2; ++db) o[db] = MFMA32(vfr[s][db], pf, o[db]); }
}
__device__ __forceinline__ void sb_fetch(const bf16* qg, const bf16* kg, const bf16* vg, int q0, int tid, v4u (&k6)[6], v4u (&v6)[6], v4u (&qw)[4]) {
    const int srow = tid >> 3, scc = tid & 7, ln = tid & 63, qpos = q0 + 32 * (tid >> 6) + (ln & 31);
#pragma unroll
    for (int p = 0; p < 6; ++p) { const int pos = q0 - 128 + p * 64 + srow; k6[p] = (v4u){0u, 0u, 0u, 0u}; v6[p] = (v4u){0u, 0u, 0u, 0u};
        if (pos >= 0) { k6[p] = *(const v4u*)(kg + (size_t)pos * 64 + 8 * scc); v6[p] = *(const v4u*)(vg + (size_t)pos * 64 + 8 * scc); } }
#pragma unroll
    for (int ds = 0; ds < 4; ++ds) qw[ds] = *(const v4u*)(qg + (size_t)qpos * 64 + 16 * ds + 8 * (ln >> 5));
}
__device__ __forceinline__ void sb_unit(LAS unsigned char* lds, const bf16* qg, const bf16* kg, const bf16* vg, int q0, bf16* og, int tid_, int lane_, int wave,
                                        v4u (&k6)[6], v4u (&v6)[6], v4u (&qwd)[4], bool has_next, const bf16* nqg, const bf16* nkg, const bf16* nvg, int nq0) {
    int lane = lane_; asm volatile("" : "+v"(lane)); const int tid = wave * 64 + lane; (void)tid_;
    constexpr int CB = 128 * KP;
    LAS unsigned char* Kl = lds; LAS unsigned char* Vl = lds + 384 * KP; LAS int* flags = (LAS int*)(lds + 2 * 384 * KP + 8192);
    const int r = lane & 31, h = lane >> 5, qw = q0 + 32 * wave, qpos = qw + r;
    const int srow = tid >> 3, scc = tid & 7;
    __syncthreads();
#pragma unroll
    for (int p = 0; p < 6; ++p) { *(LAS v4u*)(Kl + (p * 64 + srow) * KP + 16 * scc) = k6[p]; *(LAS v4u*)(Vl + (p * 64 + srow) * KP + 16 * scc) = v6[p]; }
    bf16x8 qf[4];
#pragma unroll
    for (int ds = 0; ds < 4; ++ds) { float f[8]; UNPACK8(qwd[ds], f);
        v4u o; o.x = pk2(f[0] * 0.125f, f[1] * 0.125f); o.y = pk2(f[2] * 0.125f, f[3] * 0.125f); o.z = pk2(f[4] * 0.125f, f[5] * 0.125f); o.w = pk2(f[6] * 0.125f, f[7] * 0.125f);
        qf[ds] = __builtin_bit_cast(bf16x8, o); }
    __syncthreads();
    if (has_next) sb_fetch(nqg, nkg, nvg, nq0, tid, k6, v6, qwd);
    float R = 1.f; bool wdone = false;
    f32x16 o[2];
#pragma unroll
    for (int i = 0; i < 16; ++i) { o[0][i] = 0.f; o[1][i] = 0.f; }
    {
        const LAS unsigned char* ka = Kl + kvperm(r) * KP + 16 * h;
        const LAS unsigned char* va = Vl + (16 * h + ((lane & 15) >> 2)) * KP + ((lane >> 4) & 1) * 32 + (lane & 3) * 8;
        for (int tl = 4 + wave; tl >= 0; --tl) {
            if (q0 - 128 + 32 * tl < 0) break;
            sb_tile(ka + tl * 32 * KP, va + tl * 32 * KP, tl == 4 + wave, r, h, qf, R, o);
            if (__all(R < 1e-36f)) { wdone = true; break; }
        }
    }
    int kc = q0 - 256; const int nch = (q0 >= 256) ? (q0 - 128) / 128 : 0;
    if (lane == 0) flags[16 + wave] = wdone ? 1 : 0;
    __syncthreads();
    { int alld = 1;
#pragma unroll
      for (int w = 0; w < 8; ++w) alld &= flags[16 + w];
      if (!alld && nch > 0) {
        LAS unsigned char* Kb = lds; LAS unsigned char* Vb = lds + 2 * CB;
        v4u kr[2], vr[2];
#pragma unroll
        for (int p = 0; p < 2; ++p) { kr[p] = *(const v4u*)(kg + (size_t)(kc + srow + 64 * p) * 64 + 8 * scc); vr[p] = *(const v4u*)(vg + (size_t)(kc + srow + 64 * p) * 64 + 8 * scc); }
#pragma unroll
        for (int p = 0; p < 2; ++p) { *(LAS v4u*)(Kb + (srow + 64 * p) * KP + 16 * scc) = kr[p]; *(LAS v4u*)(Vb + (srow + 64 * p) * KP + 16 * scc) = vr[p]; }
        __syncthreads();
        for (int ch = 0; ch < nch; ++ch) {
            const int buf = ch & 1; const bool has_next = ch + 1 < nch;
            if (has_next) {
#pragma unroll
                for (int p = 0; p < 2; ++p) { kr[p] = *(const v4u*)(kg + (size_t)(kc - 128 + srow + 64 * p) * 64 + 8 * scc); vr[p] = *(const v4u*)(vg + (size_t)(kc - 128 + srow + 64 * p) * 64 + 8 * scc); }
            }
            if (!wdone) {
                const LAS unsigned char* ka = Kb + buf * CB + kvperm(r) * KP + 16 * h;
                const LAS unsigned char* va = Vb + buf * CB + (16 * h + ((lane & 15) >> 2)) * KP + ((lane >> 4) & 1) * 32 + (lane & 3) * 8;
                for (int tt = 3; tt >= 0; --tt) { sb_tile(ka + tt * 32 * KP, va + tt * 32 * KP, false, r, h, qf, R, o); if (__all(R < 1e-36f)) { wdone = true; break; } }
            }
            if (has_next) {
#pragma unroll
                for (int p = 0; p < 2; ++p) { *(LAS v4u*)(Kb + (buf ^ 1) * CB + (srow + 64 * p) * KP + 16 * scc) = kr[p]; *(LAS v4u*)(Vb + (buf ^ 1) * CB + (srow + 64 * p) * KP + 16 * scc) = vr[p]; }
            }
            if (lane == 0) flags[buf * 8 + wave] = wdone ? 1 : 0;
            __syncthreads();
            int alld2 = 1;
#pragma unroll
            for (int w = 0; w < 8; ++w) alld2 &= flags[buf * 8 + w];
            if (alld2) break;
            kc -= 128;
        }
      } }
    store_ot(og + (size_t)qpos * 64, o, 1.0f, h);
}
struct Args { const float* in[16]; float* out; unsigned char* ws; };

__device__ __forceinline__ void transpose_item(const float* W, int K, int N, bf16* WT, LAS float* scr, int item, int lane, bool perm_up = false, const float* gk = nullptr, bool perm_in = false) {
    const int nblk = N / 32, kb = item / nblk, nb = item % nblk, k0 = 64 * kb, n0 = 32 * nb;
    int d0 = n0; if (perm_up) { const int bj = n0 / DFF, ch = n0 % DFF; d0 = 256 * (ch >> 7) + 128 * bj + (ch & 127); }
    if (perm_in) { const int o = n0 & 255; d0 = (n0 & ~255) + 128 * ((o >> 5) & 1) + 32 * (o >> 6); }
    float wv[32];
#pragma unroll
    for (int i = 0; i < 32; ++i) wv[i] = W[(size_t)(k0 + 2 * i + (lane >> 5)) * N + n0 + (lane & 31)];
#pragma unroll
    for (int i = 0; i < 32; ++i) scr[(2 * i + (lane >> 5)) * 33 + (lane & 31)] = wv[i];
    LDS_WAIT(); asm volatile("" ::: "memory");
    const int c = lane & 7;
    f32x4 ga = {1.f, 1.f, 1.f, 1.f}, gb = {1.f, 1.f, 1.f, 1.f}; if (gk) { ga = *(const f32x4*)(gk + k0 + 8 * c); gb = *(const f32x4*)(gk + k0 + 8 * c + 4); }
#pragma unroll
    for (int j = 0; j < 4; ++j) { const int n = (lane >> 3) + 8 * j; const LAS float* s = scr + (8 * c) * 33 + n;
        v4u o; o.x = pk2(s[0 * 33] * ga.x, s[1 * 33] * ga.y); o.y = pk2(s[2 * 33] * ga.z, s[3 * 33] * ga.w); o.z = pk2(s[4 * 33] * gb.x, s[5 * 33] * gb.y); o.w = pk2(s[6 * 33] * gb.z, s[7 * 33] * gb.w);
        *(v4u*)(WT + (size_t)(d0 + n) * K + k0 + 8 * c) = o; }
    LDS_WAIT(); asm volatile("" ::: "memory");
}
__device__ __forceinline__ void rms_row(const float* xrow, const float* g, bf16* orow, int lane) {
    const f32x4* xr = (const f32x4*)xrow + lane; const f32x4* gr = (const f32x4*)g + lane;
    f32x4 v[8]; float s = 0.f;
#pragma unroll
    for (int j = 0; j < 8; ++j) { v[j] = xr[64 * j]; s += (v[j].x * v[j].x + v[j].y * v[j].y) + (v[j].z * v[j].z + v[j].w * v[j].w); }
    const float rstd = 1.0f / sqrtf(wave_sum(s) * (1.0f / DM) + EPS);
    unsigned long long* o8 = (unsigned long long*)orow + lane;
#pragma unroll
    for (int j = 0; j < 8; ++j) { const f32x4 gv = gr[64 * j];
        o8[64 * j] = (unsigned long long)pk2(v[j].x * rstd * gv.x, v[j].y * rstd * gv.y) | ((unsigned long long)pk2(v[j].z * rstd * gv.z, v[j].w * rstd * gv.w) << 32); }
}
__device__ __forceinline__ void xrow_prep(const float* xrow, bf16* orow, float* rs, int lane) {
    const f32x4* xr = (const f32x4*)xrow + lane; f32x4 v[8]; float s = 0.f;
#pragma unroll
    for (int j = 0; j < 8; ++j) { v[j] = xr[64 * j]; s += (v[j].x * v[j].x + v[j].y * v[j].y) + (v[j].z * v[j].z + v[j].w * v[j].w); }
    s = wave_sum(s);
    unsigned long long* o8 = (unsigned long long*)orow + lane;
#pragma unroll
    for (int j = 0; j < 8; ++j) o8[64 * j] = (unsigned long long)pk2(v[j].x, v[j].y) | ((unsigned long long)pk2(v[j].z, v[j].w) << 32);
    if (lane == 0) *rs = 1.0f / sqrtf(s * (1.0f / DM) + EPS);
}
__device__ __forceinline__ void rstd_pass(const float* slots, float* rstd, int gtid, int nthreads) {
    for (int row = gtid; row < MTOK; row += nthreads) { const f32x4* p = (const f32x4*)(slots + (size_t)row * 32); f32x4 a = p[0];
#pragma unroll
        for (int j = 1; j < 8; ++j) a = a + p[j];
        rstd[row] = 1.0f / sqrtf(((a.x + a.y) + (a.z + a.w)) * (1.0f / DM) + EPS); }
}
__device__ __forceinline__ int t5_bucket(int d) {
    if (d < 16) return d;
    const float v = logf((float)d / 16.0f) / 4.852030263919617f * 16.0f;
    const int large = 16 + (int)v;
    return large < 31 ? large : 31;
}
__device__ __forceinline__ float red8(float v) { return red8_dpp(v); }
__device__ __forceinline__ void finalize8(const bf16* att, const float* lse, const float* g, bf16* mix, int tok0, int lane_) {
    int lane = lane_; asm volatile("" : "+v"(lane));
    const int ts = lane >> 3, ck = lane & 7, tok = tok0 + ts, t0 = tok0 & (SEQ - 1);
    const int b = __builtin_amdgcn_readfirstlane(tok0 >> 12);
    const char* ab = (const char*)(att + ((size_t)b * 64) * SEQ * 64 + (size_t)t0 * 64);
    const unsigned lo = (unsigned)(ts * 64 + 8 * ck) * 2u;
    bf16* mr = mix + (size_t)tok * DM + 8 * ck;
#pragma unroll
    for (int grp = 0; grp < 2; ++grp) {
        v4u w[8]; float ss = 0.f;
#pragma unroll
        for (int s = 0; s < 8; ++s) { w[s] = *(const v4u*)(ab + (size_t)(8 * grp + s) * SEQ * 128 + lo); float f[8]; UNPACK8(w[s], f);
#pragma unroll
            for (int e = 0; e < 8; ++e) ss += f[e] * f[e]; }
        const float rn = 1.0f / sqrtf(red8(ss) * (1.0f / 512.0f) + EPS);
#pragma unroll
        for (int s = 0; s < 8; ++s) { float f[8]; UNPACK8(w[s], f); const float* gg = g + 512 * grp + 64 * s + 8 * ck; const f32x4 g0 = *(const f32x4*)gg, g1 = *(const f32x4*)(gg + 4);
            v4u o; o.x = pk2(f[0] * rn * g0.x, f[1] * rn * g0.y); o.y = pk2(f[2] * rn * g0.z, f[3] * rn * g0.w); o.z = pk2(f[4] * rn * g1.x, f[5] * rn * g1.y); o.w = pk2(f[6] * rn * g1.z, f[7] * rn * g1.w);
            *(v4u*)(mr + 512 * grp + 64 * s) = o; }
        asm volatile("" ::: "memory");
    }
    {
        v4u cpk[16]; float ss = 0.f;
        const float* lp = lse + (size_t)tok * 16;
#pragma unroll
        for (int hh = 0; hh < 16; ++hh) {
            float ls[3], mx = -1e30f;
#pragma unroll
            for (int br = 0; br < 3; ++br) { ls[br] = lp[(size_t)br * MTOK * 16 + hh]; mx = fmaxf(mx, ls[br]); }
            float wsum = 0.f;
#pragma unroll
            for (int br = 0; br < 3; ++br) { ls[br] = __expf(ls[br] - mx); wsum += ls[br]; }
            const float winv = __builtin_amdgcn_rcpf(wsum);
            float c[8];
#pragma unroll
            for (int e = 0; e < 8; ++e) c[e] = 0.f;
#pragma unroll
            for (int br = 0; br < 3; ++br) { const v4u w = *(const v4u*)(ab + (size_t)(16 + 16 * br + hh) * SEQ * 128 + lo); float f[8]; UNPACK8(w, f); const float wb = ls[br] * winv;
#pragma unroll
                for (int e = 0; e < 8; ++e) c[e] += wb * f[e]; }
#pragma unroll
            for (int e = 0; e < 8; ++e) ss += c[e] * c[e];
            cpk[hh].x = pk2(c[0], c[1]); cpk[hh].y = pk2(c[2], c[3]); cpk[hh].z = pk2(c[4], c[5]); cpk[hh].w = pk2(c[6], c[7]);
            if (hh & 1) asm volatile("" ::: "memory");
        }
        const float rn = 1.0f / sqrtf(red8(ss) * (1.0f / 1024.0f) + EPS);
#pragma unroll
        for (int hh = 0; hh < 16; ++hh) { float c[8]; UNPACK8(cpk[hh], c); const float* gg = g + 1024 + 64 * hh + 8 * ck; const f32x4 g0 = *(const f32x4*)gg, g1 = *(const f32x4*)(gg + 4);
            v4u o; o.x = pk2(c[0] * rn * g0.x, c[1] * rn * g0.y); o.y = pk2(c[2] * rn * g0.z, c[3] * rn * g0.w); o.z = pk2(c[4] * rn * g1.x, c[5] * rn * g1.y); o.w = pk2(c[6] * rn * g1.z, c[7] * rn * g1.w);
            *(v4u*)(mr + 1024 + 64 * hh) = o;
            if (hh & 1) asm volatile("" ::: "memory"); }
    }
}
__device__ __forceinline__ void conv_item(const bf16* u, const float* cw, const float* cb, bf16* act, int item, int lane) {
    const int slab = item % 11, chunk = item / 11, f0 = slab * 512 + lane * 8, tok0 = chunk * 64;
    float wg[3][8], wu[3][8], bg[8], bu[8];
#pragma unroll
    for (int i = 0; i < 3; ++i)
#pragma unroll
        for (int e = 0; e < 8; ++e) { wg[i][e] = cw[i * UW + f0 + e]; wu[i][e] = cw[i * UW + DFF + f0 + e]; }
#pragma unroll
    for (int e = 0; e < 8; ++e) { bg[e] = cb[f0 + e]; bu[e] = cb[DFF + f0 + e]; }
    float g1[8], g2[8], u1[8], u2[8];
    if ((tok0 & (SEQ - 1)) == 0) {
#pragma unroll
        for (int e = 0; e < 8; ++e) { g1[e] = 0.f; g2[e] = 0.f; u1[e] = 0.f; u2[e] = 0.f; }
    } else {
        const bf16* r1 = u + (size_t)(tok0 - 1) * UW + f0; const bf16* r2 = u + (size_t)(tok0 - 2) * UW + f0;
        { const v4u w = *(const v4u*)r1; UNPACK8(w, g1); } { const v4u w = *(const v4u*)(r1 + DFF); UNPACK8(w, u1); }
        { const v4u w = *(const v4u*)r2; UNPACK8(w, g2); } { const v4u w = *(const v4u*)(r2 + DFF); UNPACK8(w, u2); }
    }
#pragma unroll 4
    for (int t = 0; t < 64; ++t) {
        const bf16* r0 = u + (size_t)(tok0 + t) * UW + f0;
        float g0[8], u0[8], o[8];
        { const v4u w = *(const v4u*)r0; UNPACK8(w, g0); } { const v4u w = *(const v4u*)(r0 + DFF); UNPACK8(w, u0); }
#pragma unroll
        for (int e = 0; e < 8; ++e) {
            const float gv = bg[e] + wg[0][e] * g2[e] + wg[1][e] * g1[e] + wg[2][e] * g0[e];
            const float uv = bu[e] + wu[0][e] * u2[e] + wu[1][e] * u1[e] + wu[2][e] * u0[e];
            o[e] = gv / (1.0f + __expf(-gv)) * uv;
            g2[e] = g1[e]; g1[e] = g0[e]; u2[e] = u1[e]; u1[e] = u0[e];
        }
        v4u ov; ov.x = pk2(o[0], o[1]); ov.y = pk2(o[2], o[3]); ov.z = pk2(o[4], o[5]); ov.w = pk2(o[6], o[7]);
        *(v4u*)(act + (size_t)(tok0 + t) * DFF + f0) = ov;
    }
}

#ifndef REV_DOWN
#define REV_DOWN 1
#endif
#ifndef REV_ATT
#define REV_ATT 1
#endif
#ifndef WGM_IN
#define WGM_IN 4
#define WGM_OUT 4
#define WGM_UP 4
#define WGM_DOWN 4
#endif
#define PHASE_BEGIN() \
    int zs_ = 0; asm volatile("" : "+s"(zs_)); zs_ = __builtin_amdgcn_readfirstlane(zs_);     \
    const Args* ap = (const Args*)((const char*)__builtin_amdgcn_kernarg_segment_ptr() + zs_); \
    unsigned lz_ = 0u; asm volatile("" : "+v"(lz_)); const int lane = __builtin_amdgcn_mbcnt_hi(~0u, __builtin_amdgcn_mbcnt_lo(~0u, lz_)); \
    const int wave = wave_s + zs_, G = (int)gridDim.x + zs_, bx = (int)blockIdx.x + zs_; \
    const int tid = wave * 64 + lane; const int gw = bx * NWAVES + wave, NGW = G * NWAVES; \
    unsigned char* ws = ap->ws; (void)tid; (void)gw; (void)NGW; (void)ws
#define GRID_BAR() do { int zb_ = 0; asm volatile("" : "+s"(zb_)); zb_ = __builtin_amdgcn_readfirstlane(zb_); const Args* apb_ = (const Args*)((const char*)__builtin_amdgcn_kernarg_segment_ptr() + zb_); \
    XcdBarrier b_; b_.bar = (unsigned*)(apb_->ws + WS_CTL); b_.x = xb_xcc_id(); b_.st = (volatile LAS unsigned*)(lds + 131072); xcd_barrier(b_, wave_s + zb_); } while (0)
__global__ void __launch_bounds__(NWAVES * 64, 2) fwd_mega(Args args_unused) {
    extern __shared__ __attribute__((aligned(16))) unsigned char lds_raw[];
    cg::grid_group grid = cg::this_grid();
    LAS unsigned char* lds = (LAS unsigned char*)lds_raw;
    const int wave_s = __builtin_amdgcn_readfirstlane(threadIdx.x >> 6);
    volatile LAS unsigned* bar_st = (volatile LAS unsigned*)(lds + 131072);
    if (threadIdx.x < 2) bar_st[threadIdx.x] = 0u;
    __syncthreads();
    { const Args* ap0 = (const Args*)__builtin_amdgcn_kernarg_segment_ptr(); (void)xcd_barrier_post((unsigned*)(ap0->ws + WS_CTL), bar_st); }

#pragma nounroll
    for (int l = 0; l < DEPTH; ++l) {
        {
            PHASE_BEGIN();
            LAS float* scr = (LAS float*)(lds + wave * 16384);
            const float* w_in = ap->in[2] + (size_t)l * DM * PW; bf16* Wt_in = (bf16*)(ws + WS_WIN);
            constexpr int I_IN = (DM / 64) * (PW / 32);
            for (int it = gw; it < I_IN; it += NGW) transpose_item(w_in, DM, PW, Wt_in, scr, it, lane, false, ap->in[1] + (size_t)l * DM, true);
            if (l == 0) { const float* xin = ap->in[0]; bf16* XB1 = (bf16*)(ws + WS_R2); float* RSTD1 = (float*)(ws + WS_RSTD1);
              for (int m = gw; m < MTOK; m += NGW) xrow_prep(xin + (size_t)m * DM, XB1 + (size_t)m * DM, RSTD1 + m, lane); }
            else rstd_pass((const float*)(ws + WS_RS1), (float*)(ws + WS_RSTD1), bx * 512 + tid, G * 512);
            if (l == 0) { float* B2 = (float*)(ws + WS_BIAS); const float* rel_tab = ap->in[8];
                for (int i = bx * 512 + tid; i < 4 * 16 * 160; i += G * 512) { const int cfg = i / 2560, rr = i % 2560, hh = rr / 160, j = rr % 160; const int dil = cfg <= 1 ? 1 : (cfg == 2 ? 4 : 16);
                    float v = 0.f; if (j <= 128) { if (cfg == 0) { if (hh < 8) v = rel_tab[t5_bucket(j) * 24 + hh]; } else v = rel_tab[t5_bucket(j * dil) * 24 + 8 + hh]; }
                    B2[i] = v * LOG2E; } }
            if (bx == 0 && tid < 128) { float* GQ = (float*)(ws + WS_GQK);
                GQ[tid] = tid < 64 ? ap->in[3][l * 64 + tid] * ap->in[4][l * 64 + tid] : ap->in[6][l * 64 + tid - 64] * ap->in[7][l * 64 + tid - 64]; }
        }
        if (l == 0) grid.sync(); else GRID_BAR();
        {
            PHASE_BEGIN();
            pg8::Gemm g{(const bf16*)(ws + WS_R2), (const bf16*)(ws + WS_WIN), MTOK, PW, DM}; pg8::StaticOrder S; S.init(MTOK, PW, G, bx, WGM_IN);
            pg8::EpiBf16s E{(bf16*)(ws + WS_R1), (const float*)(ws + WS_RSTD1), ap->in[3] + l * 64, ap->in[4] + l * 64, ap->in[6] + l * 64, ap->in[7] + l * 64};
            pg8::gemm_phase<pg8::EpiBf16s, pg8::StaticOrder, true, true>(lds, g, S, E, tid);
            { constexpr int NT_IN = (MTOK / 256) * (PW / 256); const int nfull = NT_IN % G;
              if (nfull > 0 && bx >= nfull) {
                  LAS float* scr = (LAS float*)(lds + wave * 16384);
                  const float* w_out = ap->in[10] + (size_t)l * DM * DM; const float* w_down = ap->in[15] + (size_t)l * DFF * DM; const float* w_up = ap->in[12] + (size_t)l * DM * UW;
                  bf16* Wt_out = (bf16*)(ws + WS_WOUT); bf16* Wt_down = (bf16*)(ws + WS_WDOWN); bf16* Wt_up = (bf16*)(ws + WS_WUP);
                  constexpr int I_OUT = (DM / 64) * (DM / 32), I_DOWN = (DFF / 64) * (DM / 32), I_UP = (DM / 64) * (UW / 32);
                  const int nw = (G - nfull) * NWAVES;
                  for (int it = (bx - nfull) * NWAVES + wave; it < I_OUT + I_DOWN + I_UP; it += nw) {
                      if (it < I_OUT) transpose_item(w_out, DM, DM, Wt_out, scr, it, lane); else if (it < I_OUT + I_DOWN) transpose_item(w_down, DFF, DM, Wt_down, scr, it - I_OUT, lane);
                      else transpose_item(w_up, DM, UW, Wt_up, scr, it - I_OUT - I_DOWN, lane, true, ap->in[11] + (size_t)l * DM); }
              } else if (nfull == 0) {
                  LAS float* scr = (LAS float*)(lds + wave * 16384);
                  const float* w_out = ap->in[10] + (size_t)l * DM * DM; const float* w_down = ap->in[15] + (size_t)l * DFF * DM; const float* w_up = ap->in[12] + (size_t)l * DM * UW;
                  bf16* Wt_out = (bf16*)(ws + WS_WOUT); bf16* Wt_down = (bf16*)(ws + WS_WDOWN); bf16* Wt_up = (bf16*)(ws + WS_WUP);
                  constexpr int I_OUT = (DM / 64) * (DM / 32), I_DOWN = (DFF / 64) * (DM / 32), I_UP = (DM / 64) * (UW / 32);
                  for (int it = gw; it < I_OUT + I_DOWN + I_UP; it += NGW) {
                      if (it < I_OUT) transpose_item(w_out, DM, DM, Wt_out, scr, it, lane); else if (it < I_OUT + I_DOWN) transpose_item(w_down, DFF, DM, Wt_down, scr, it - I_OUT, lane);
                      else transpose_item(w_up, DM, UW, Wt_up, scr, it - I_OUT - I_DOWN, lane, true, ap->in[11] + (size_t)l * DM); }
              } }
        }
        GRID_BAR();
        {
            PHASE_BEGIN();
            const bf16* PROJ = (const bf16*)(ws + WS_R1); bf16* ATT = (bf16*)(ws + WS_ATT); float* LSE = (float*)(ws + WS_LSE);
            const float* B2 = (const float*)(ws + WS_BIAS); const float* GQ = (const float*)(ws + WS_GQK); const float* a_sinks = ap->in[5] + l * 8;
            int u = bx;
            if (u < 1024) {
                v4u k6[6], v6[6], qw[4];
#define SB_DECODE(U, PB, Q0, OG) const int b_##PB = REV_ATT ? 7 - ((U) >> 7) : ((U) >> 7), hh_##PB = ((U) >> 4) & 7; const bf16* PB = PROJ + ((size_t)b_##PB * 84 + hh_##PB) * SEQ * 64; \
                const int Q0 = ((U) & 15) * 256; bf16* OG = ATT + ((size_t)b_##PB * 64 + 8 + hh_##PB) * SEQ * 64
                { SB_DECODE(u, pb0, q00, og0); (void)og0; sb_fetch(pb0 + (size_t)12 * SEQ * 64, pb0 + (size_t)20 * SEQ * 64, pb0 + (size_t)28 * SEQ * 64, q00, tid, k6, v6, qw); }
                for (;;) { const int un = u + G; const bool has_next = un < 1024; const int unc = has_next ? un : u;
                    SB_DECODE(u, pbc, q0c, ogc); SB_DECODE(unc, pbn, q0n, ogn); (void)ogn;
                    sb_unit(lds, pbc + (size_t)12 * SEQ * 64, pbc + (size_t)20 * SEQ * 64, pbc + (size_t)28 * SEQ * 64, q0c, ogc, tid, lane, wave, k6, v6, qw, has_next,
                            pbn + (size_t)12 * SEQ * 64, pbn + (size_t)20 * SEQ * 64, pbn + (size_t)28 * SEQ * 64, q0n);
                    u = un; if (!has_next) break; }
#undef SB_DECODE
            }
            if (u < 8192) {
                v4u kr[6], vr[6], qw[4]; float bv;
                LAS float* gqkL = (LAS float*)(lds + 2 * 384 * KP + 384 * 4 + 192 * 4);
                if (tid < 128) gqkL[tid] = GQ[tid];
                BandCfg c = band_cfg(u, PROJ, ATT, LSE, B2, GQ, a_sinks);
                band_fetch(c, tid, kr, vr, bv, qw);
                for (;;) { const int un = u + G; const bool has_next = un < 8192;
                    BandCfg cn = c;
                    banded_unit(lds, c, tid, lane, wave, kr, vr, bv, qw, gqkL + c.gqk, has_next, un, cn, PROJ, ATT, LSE, B2, a_sinks);
                    if (!has_next) break;
                    c = cn; u = un; }
            }
            __syncthreads();
        }
        GRID_BAR();
        { PHASE_BEGIN(); const float* mix_gain = ap->in[9] + (size_t)l * DM; const bf16* ATT = (const bf16*)(ws + WS_ATT); const float* LSE = (const float*)(ws + WS_LSE); bf16* MIX = (bf16*)(ws + WS_MIX);
          for (int m8 = gw; m8 < MTOK / 8; m8 += NGW) finalize8(ATT, LSE, mix_gain, MIX, m8 * 8, lane); }
        GRID_BAR();
        {
            PHASE_BEGIN();
            pg8::Gemm g{(const bf16*)(ws + WS_MIX), (const bf16*)(ws + WS_WOUT), MTOK, DM, DM}; pg8::StaticOrder S; S.init(MTOK, DM, G, bx, WGM_OUT);
            pg8::EpiRes E{(l == 0) ? ap->in[0] : (const float*)nullptr, (const bf16*)(ws + WS_R2), (float*)nullptr, (bf16*)(ws + WS_XB2), (float*)(ws + WS_RS2), DM};
            pg8::gemm_phase<pg8::EpiRes, pg8::StaticOrder, true, true>(lds, g, S, E, tid);
        }
        GRID_BAR();
        { PHASE_BEGIN(); rstd_pass((const float*)(ws + WS_RS2), (float*)(ws + WS_RSTD2), bx * 512 + tid, G * 512); }
        GRID_BAR();
        {
            PHASE_BEGIN();
            pg8::Gemm g{(const bf16*)(ws + WS_XB2), (const bf16*)(ws + WS_WUP), MTOK, UW, DM}; pg8::StaticOrder S; S.init(MTOK, UW, G, bx, WGM_UP);
            pg8::EpiConvGate E{(bf16*)(ws + WS_R1), ap->in[13] + (size_t)l * 3 * UW, ap->in[14] + (size_t)l * UW, (float*)(ws + WS_UH), (LAS float*)(lds + LDS_XCH), (const float*)(ws + WS_RSTD2)};
            pg8::gemm_phase<pg8::EpiConvGate, pg8::StaticOrder, true, true>(lds, g, S, E, tid);
        }
        GRID_BAR();
        { PHASE_BEGIN(); const float* cw = ap->in[13] + (size_t)l * 3 * UW; const float* cb = ap->in[14] + (size_t)l * UW; const float* uh = (const float*)(ws + WS_UH); bf16* ACT = (bf16*)(ws + WS_R1);
          for (int idx = bx * 512 + tid; idx < 128 * DFF; idx += G * 512) { const int pm = idx / DFF, ch = idx % DFF; if ((pm & 15) == 0) continue;
              const int pos = 256 * (ch >> 7) + (ch & 127); const float* a = uh + (size_t)(pm - 1) * 4 * UW + pos; const float* b = uh + (size_t)pm * 4 * UW + pos;
              const float gm2 = a[2 * UW], gm1 = a[3 * UW], g0 = b[0], g1 = b[UW], um2 = a[2 * UW + 128], um1 = a[3 * UW + 128], u0 = b[128], u1 = b[UW + 128];
              const float wg0 = cw[ch], wg1 = cw[UW + ch], wg2 = cw[2 * UW + ch], wu0 = cw[DFF + ch], wu1 = cw[UW + DFF + ch], wu2 = cw[2 * UW + DFF + ch], bg = cb[ch], bu = cb[DFF + ch];
              { const float gv = bg + wg0 * gm2 + wg1 * gm1 + wg2 * g0, uv = bu + wu0 * um2 + wu1 * um1 + wu2 * u0; ACT[(size_t)(pm * 256) * DFF + ch] = (bf16)f2bf(gv / (1.0f + __expf(-gv)) * uv); }
              { const float gv = bg + wg0 * gm1 + wg1 * g0 + wg2 * g1, uv = bu + wu0 * um1 + wu1 * u0 + wu2 * u1; ACT[(size_t)(pm * 256 + 1) * DFF + ch] = (bf16)f2bf(gv / (1.0f + __expf(-gv)) * uv); } } }
        GRID_BAR();
        {
            PHASE_BEGIN();
            pg8::Gemm g{(const bf16*)(ws + WS_R1), (const bf16*)(ws + WS_WDOWN), MTOK, DM, DFF}; pg8::StaticOrder S; S.init(MTOK, DM, G, bx, WGM_DOWN, REV_DOWN);
            pg8::EpiRes E{(const float*)nullptr, (const bf16*)(ws + WS_XB2), (l == DEPTH - 1) ? ap->out : (float*)nullptr, (bf16*)(ws + WS_R2), (float*)(ws + WS_RS1), DM};
            pg8::gemm_phase<pg8::EpiRes, pg8::StaticOrder, true, true>(lds, g, S, E, tid);
        }
        GRID_BAR();
    }
}

extern "C" void kernel_launch(void* const* d_in, const int* in_sizes, int n_in, void* d_out, int out_size, void* d_ws, size_t ws_size, hipStream_t stream) {
    static int grid = 0;
    if (grid == 0) {
        if (n_in != 16 || out_size != MTOK * DM || ws_size < WS_END) { fprintf(stderr, "kernel_launch: unexpected shapes (n_in %d out %d ws %zu)\n", n_in, out_size, ws_size); grid = -1; return; }
        int dev = 0, cus = 0, per_cu = 0;
        (void)hipGetDevice(&dev); (void)hipDeviceGetAttribute(&cus, hipDeviceAttributeMultiprocessorCount, dev);
        if (hipFuncSetAttribute((const void*)fwd_mega, hipFuncAttributeMaxDynamicSharedMemorySize, LDS_BYTES) != hipSuccess) { fprintf(stderr, "kernel_launch: hipFuncSetAttribute failed\n"); grid = -1; return; }
        if (hipOccupancyMaxActiveBlocksPerMultiprocessor(&per_cu, (const void*)fwd_mega, NWAVES * 64, LDS_BYTES) != hipSuccess || per_cu < 1) { fprintf(stderr, "kernel_launch: occupancy query says %d\n", per_cu); per_cu = 1; }
        (void)hipGetLastError();
        grid = cus * per_cu;
        fprintf(stderr, "kernel_launch: grid %d (cus %d x %d)\n", grid, cus, per_cu);
    }
    if (grid < 0) return;
    if (hipMemsetAsync((char*)d_ws + WS_CTL, 0, 16384, stream) != hipSuccess) { fprintf(stderr, "kernel_launch: memset of barrier words failed\n"); return; }
    Args a{};
    for (int i = 0; i < 16; ++i) a.in[i] = (const float*)d_in[i];
    a.out = (float*)d_out; a.ws = (unsigned char*)d_ws;
    void* kargs[] = {&a};
    hipError_t e = hipLaunchCooperativeKernel((const void*)fwd_mega, dim3(grid), dim3(NWAVES * 64), kargs, LDS_BYTES, stream);
    if (e != hipSuccess) fprintf(stderr, "cooperative launch failed: %s (grid %d)\n", hipGetErrorString(e), grid);
}
```

```cpp
#include <hip/hip_runtime.h>
#include <hip/hip_cooperative_groups.h>
#include <cstdio>
#include <cstdint>
namespace cg = cooperative_groups;
#define WGM_IN 4
#define WGM_OUT 4
#define WGM_UP 4
#define WGM_DOWN 2
namespace pg8 {
#define PG8_LAS __attribute__((address_space(3)))
typedef unsigned short bf16_t;
typedef short bf16x8 __attribute__((ext_vector_type(8)));
typedef float f32x4 __attribute__((ext_vector_type(4)));
typedef unsigned u32x4 __attribute__((ext_vector_type(4)));
constexpr int BM = 256, BK = 64, HALF = 128, HTB = HALF * BK * 2  , STAGE_BYTES = 8 * HTB, NXCD = 8, WGM = 8;

__host__ __device__ __forceinline__ int lds_byte(int r, int c) { const int st = (r >> 4) * 2 + (c >> 5), rr = r & 15, cc = c & 31, ob = rr * 64 + cc * 2; return st * 1024 + (ob ^ (((ob >> 9) & 1) << 5)); }
__host__ __device__ __forceinline__ void stage_rc(int b, int& R, int& C) { const int st = b / 1024, sb = b % 1024, swz = sb ^ (((sb >> 9) & 1) << 5); R = (st >> 1) * 16 + swz / 64; C = (st & 1) * 32 + (swz % 64) / 2; }
__host__ __device__ __forceinline__ int perm32(int rho) { const int n = rho >> 4, i = rho & 15; return 8 * (i >> 2) + 4 * n + (i & 3); }

struct Unit { int pm, pn; };
struct Gemm { const bf16_t* A; const bf16_t* Bt; int M, N, K; };

struct StaticOrder {
    int nM, nN, nwg, G, c, wgm, rev;
    __host__ __device__ void init(int M, int N, int G_, int c_, int wgm_ = 4, int rev_ = 0) { nM = M / BM; nN = N / BM; nwg = nM * nN; G = G_; c = c_; wgm = wgm_; rev = rev_; }
    __host__ __device__ bool next(int i, Unit& u) const {
        const long L = (long)i * G + c; if (L >= nwg) return false;
        int wgid = (int)L; { const int q = nwg / NXCD, r = nwg % NXCD, xcd = wgid % NXCD, off = wgid / NXCD; wgid = (xcd < r ? xcd * (q + 1) : r * (q + 1) + (xcd - r) * q) + off; }
        const int nig = wgm * nN, gid = wgid / nig, fm = gid * wgm, gsz = (nM - fm) < wgm ? (nM - fm) : wgm;
        u.pm = fm + ((wgid % nig) % gsz); u.pn = (wgid % nig) / gsz; if (rev) u.pm = nM - 1 - u.pm; return true;
    }
    __device__ __forceinline__ void a_ready(const Unit&) const {}
    __device__ __forceinline__ void done(const Unit&) const {}
};

__device__ __forceinline__ unsigned cvt_pk_bf16(float lo, float hi) { unsigned r; asm volatile("v_cvt_pk_bf16_f32 %0, %1, %2" : "=v"(r) : "v"(lo), "v"(hi)); return r; }
typedef float f32x2 __attribute__((ext_vector_type(2)));
typedef unsigned u32x2 __attribute__((ext_vector_type(2)));
__device__ __forceinline__ float row_rstd(const float* rsp, int row, int fq) {
    const f32x4 a = *(const f32x4*)(rsp + (size_t)row * 32 + 8 * fq), b = *(const f32x4*)(rsp + (size_t)row * 32 + 8 * fq + 4);
    float s = ((a[0] + a[1]) + (a[2] + a[3])) + ((b[0] + b[1]) + (b[2] + b[3]));
    s += __shfl_xor(s, 16); s += __shfl_xor(s, 32);
    return 1.0f / sqrtf(s * (1.0f / 2048.0f) + 1e-6f);
}
__device__ __forceinline__ float sum_fq(float v) {
    const auto a = __builtin_amdgcn_permlane16_swap(__float_as_uint(v), __float_as_uint(v), false, false); v = __uint_as_float(a[0]) + __uint_as_float(a[1]);
    const auto b = __builtin_amdgcn_permlane32_swap(__float_as_uint(v), __float_as_uint(v), false, false); return __uint_as_float(b[0]) + __uint_as_float(b[1]);
}
__device__ __forceinline__ void row_rstd8(float (&sc)[2][4], const float* rstd, int row0, int fq) {
    (void)fq;
#pragma unroll
    for (int ai = 0; ai < 2; ++ai)
#pragma unroll
        for (int m = 0; m < 4; ++m) sc[ai][m] = rstd[row0 + ai * HALF + m * 16];
}
struct EpiBf16s {
    static constexpr bool PERM = true, AFTER_DRAIN = false, APERM = false;
    bf16_t* O; const float* rs; const float* aq; const float* ak; const float* cq; const float* ck;
    __device__ __forceinline__ void operator()(const f32x4 (&acc)[2][2][4][2], const Unit& u, int wr, int wc, int fr_, int fq_) const {
        unsigned lz_ = 0u; asm volatile("" : "+v"(lz_)); const int ln_ = __builtin_amdgcn_mbcnt_hi(~0u, __builtin_amdgcn_mbcnt_lo(~0u, lz_)); const int fr = ln_ & 15, fq = ln_ >> 4; (void)fr_; (void)fq_;
        const int row0 = u.pm * BM + wr * 64 + fr; const int slot = 4 * u.pn + wc;
        const float* gp = nullptr; float gsc = 1.0f;
        if (slot < 8) { gp = aq; gsc = 0.125f * 1.4426950408889634f; } else if (slot < 10) gp = ak; else if (slot >= 36 && slot < 52) { gp = cq; gsc = 0.125f * 1.4426950408889634f; } else if (slot >= 52 && slot < 68) gp = ck;
        f32x4 gv[2][2];
#pragma unroll
        for (int bj = 0; bj < 2; ++bj)
#pragma unroll
            for (int n = 0; n < 2; ++n) gv[bj][n] = gp ? *(const f32x4*)(gp + 32 * bj + 8 * fq + 4 * n) * gsc : (f32x4){1.f, 1.f, 1.f, 1.f};
        float scs[2][4]; row_rstd8(scs, rs, row0, fq);
#pragma unroll
        for (int ai = 0; ai < 2; ++ai)
#pragma unroll
            for (int m = 0; m < 4; ++m) { const int row = row0 + ai * HALF + m * 16; const float sc = scs[ai][m];
                f32x4 v[2][2];
#pragma unroll
                for (int bj = 0; bj < 2; ++bj)
#pragma unroll
                    for (int n = 0; n < 2; ++n) v[bj][n] = acc[ai][bj][m][n] * sc;
                if (gp) { float ss = 0.f;
#pragma unroll
                    for (int bj = 0; bj < 2; ++bj)
#pragma unroll
                        for (int n = 0; n < 2; ++n) ss += (v[bj][n][0] * v[bj][n][0] + v[bj][n][1] * v[bj][n][1]) + (v[bj][n][2] * v[bj][n][2] + v[bj][n][3] * v[bj][n][3]);
                    ss = sum_fq(ss);
                    const float f = __builtin_amdgcn_rsqf(ss * (1.0f / 64.0f) + 1e-6f);
#pragma unroll
                    for (int bj = 0; bj < 2; ++bj)
#pragma unroll
                        for (int n = 0; n < 2; ++n) v[bj][n] = v[bj][n] * (gv[bj][n] * f); }
                bf16_t* rowp = O + (((size_t)(row >> 12) * 84 + slot) * 4096 + (row & 4095)) * 64 + 8 * fq;
#pragma unroll
                for (int bj = 0; bj < 2; ++bj) { u32x4 w; w.x = cvt_pk_bf16(v[bj][0][0], v[bj][0][1]); w.y = cvt_pk_bf16(v[bj][0][2], v[bj][0][3]); w.z = cvt_pk_bf16(v[bj][1][0], v[bj][1][1]); w.w = cvt_pk_bf16(v[bj][1][2], v[bj][1][3]);
                    *(u32x4*)(rowp + 32 * bj) = w; } }
    }
};
struct EpiRes {
    static constexpr bool PERM = true, AFTER_DRAIN = false;
    const float* basef; const bf16_t* baseb; float* outf; bf16_t* outb; float* rs; int ldc;
    __device__ __forceinline__ void operator()(const f32x4 (&acc)[2][2][4][2], const Unit& u, int wr, int wc, int fr_, int fq_) const {
        unsigned lz_ = 0u; asm volatile("" : "+v"(lz_)); const int ln_ = __builtin_amdgcn_mbcnt_hi(~0u, __builtin_amdgcn_mbcnt_lo(~0u, lz_)); const int fr = ln_ & 15, fq = ln_ >> 4; (void)fr_; (void)fq_;
        const int row0 = u.pm * BM + wr * 64 + fr; const int col0 = u.pn * BM + wc * 32 + 8 * fq;
        u32x4 bw[2][2][2][2];
        if (!basef) {
#pragma unroll
            for (int ai = 0; ai < 2; ++ai)
#pragma unroll
                for (int m = 0; m < 4; ++m)
#pragma unroll
                    for (int bj = 0; bj < 2; ++bj) bw[ai][m >> 1][m & 1][bj] = *(const u32x4*)(baseb + (size_t)(row0 + ai * HALF + m * 16) * ldc + col0 + bj * HALF);
            asm volatile("" ::: "memory");
        }
#pragma unroll
        for (int ai = 0; ai < 2; ++ai)
#pragma unroll
            for (int mp = 0; mp < 2; ++mp) {
                f32x4 b[2][2][2];
#pragma unroll
                for (int mm = 0; mm < 2; ++mm) { const size_t off = (size_t)(row0 + ai * HALF + (2 * mp + mm) * 16) * ldc + col0;
#pragma unroll
                    for (int bj = 0; bj < 2; ++bj) {
                        if (basef) { b[mm][bj][0] = *(const f32x4*)(basef + off + bj * HALF); b[mm][bj][1] = *(const f32x4*)(basef + off + bj * HALF + 4); }
                        else { const u32x4 w = bw[ai][mp][mm][bj];
                            b[mm][bj][0] = (f32x4){__uint_as_float(w.x << 16), __uint_as_float(w.x & 0xffff0000u), __uint_as_float(w.y << 16), __uint_as_float(w.y & 0xffff0000u)};
                            b[mm][bj][1] = (f32x4){__uint_as_float(w.z << 16), __uint_as_float(w.z & 0xffff0000u), __uint_as_float(w.w << 16), __uint_as_float(w.w & 0xffff0000u)}; } } }
                asm volatile("" ::: "memory");
#pragma unroll
                for (int mm = 0; mm < 2; ++mm) { const int m = 2 * mp + mm, row = row0 + ai * HALF + m * 16; const size_t off = (size_t)row * ldc + col0; float ss = 0.f;
#pragma unroll
                    for (int bj = 0; bj < 2; ++bj) { const f32x4 v0 = b[mm][bj][0] + acc[ai][bj][m][0], v1 = b[mm][bj][1] + acc[ai][bj][m][1];
                        if (outf) { *(f32x4*)(outf + off + bj * HALF) = v0; *(f32x4*)(outf + off + bj * HALF + 4) = v1; }
                        else { ss += ((v0[0] * v0[0] + v0[1] * v0[1]) + (v0[2] * v0[2] + v0[3] * v0[3])) + ((v1[0] * v1[0] + v1[1] * v1[1]) + (v1[2] * v1[2] + v1[3] * v1[3]));
                            u32x4 w; w.x = cvt_pk_bf16(v0[0], v0[1]); w.y = cvt_pk_bf16(v0[2], v0[3]); w.z = cvt_pk_bf16(v1[0], v1[1]); w.w = cvt_pk_bf16(v1[2], v1[3]); *(u32x4*)(outb + off + bj * HALF) = w; } }
                    if (!outf) { ss = sum_fq(ss); if (fq == 0) rs[(size_t)row * 32 + u.pn * 4 + wc] = ss; } }
                asm volatile("" ::: "memory");
            }
    }
};
__device__ __forceinline__ float dpp_ror1(float s) { return __int_as_float(__builtin_amdgcn_mov_dpp(__float_as_int(s), 0x121, 0xf, 0xf, false)); }
__device__ __forceinline__ float dpp_ror2(float s) { return __int_as_float(__builtin_amdgcn_mov_dpp(__float_as_int(s), 0x122, 0xf, 0xf, false)); }
__device__ __forceinline__ float dpp_shr1(float old, float s) { return __int_as_float(__builtin_amdgcn_update_dpp(__float_as_int(old), __float_as_int(s), 0x111, 0xf, 0xf, false)); }
__device__ __forceinline__ float dpp_shr2(float old, float s) { return __int_as_float(__builtin_amdgcn_update_dpp(__float_as_int(old), __float_as_int(s), 0x112, 0xf, 0xf, false)); }
struct EpiConvGate {
    static constexpr bool PERM = true, AFTER_DRAIN = false;
    static constexpr int FF = 5632, UWc = 11264;
    bf16_t* act; const float* cw; const float* cb; float* uh; PG8_LAS float* xch; const float* rs;
    __device__ __forceinline__ void operator()(const f32x4 (&acc_)[2][2][4][2], const Unit& u, int wr, int wc, int fr_, int fq_) const {
        unsigned lz_ = 0u; asm volatile("" : "+v"(lz_)); const int ln_ = __builtin_amdgcn_mbcnt_hi(~0u, __builtin_amdgcn_mbcnt_lo(~0u, lz_)); const int fr = ln_ & 15, fq = ln_ >> 4; (void)fr_; (void)fq_;
        const int chl = wc * 32 + 8 * fq, ch0 = u.pn * 128 + chl;
        f32x4 (&acc)[2][2][4][2] = const_cast<f32x4 (&)[2][2][4][2]>(acc_);
        { float scs[2][4]; row_rstd8(scs, rs, u.pm * BM + wr * 64 + fr, fq);
#pragma unroll
          for (int ai = 0; ai < 2; ++ai)
#pragma unroll
              for (int m = 0; m < 4; ++m)
#pragma unroll
                  for (int bj = 0; bj < 2; ++bj)
#pragma unroll
                      for (int n = 0; n < 2; ++n) acc[ai][bj][m][n] = acc[ai][bj][m][n] * scs[ai][m]; }
        if (fr >= 14) {
#pragma unroll
            for (int ai = 0; ai < 2; ++ai)
#pragma unroll
                for (int bj = 0; bj < 2; ++bj)
#pragma unroll
                    for (int n = 0; n < 2; ++n) *(PG8_LAS f32x4*)(xch + ((2 * ai + wr) * 2 + (fr - 14)) * 256 + bj * 128 + chl + 4 * n) = acc[ai][bj][3][n];
        }
        { float* uht = uh + (size_t)u.pm * 4 * UWc + u.pn * 256 + chl;
          if (wr == 0 && fr < 2) {
#pragma unroll
              for (int bj = 0; bj < 2; ++bj)
#pragma unroll
                  for (int n = 0; n < 2; ++n) *(f32x4*)(uht + fr * UWc + bj * 128 + 4 * n) = acc[0][bj][0][n]; }
          if (wr == 1 && fr >= 14) {
#pragma unroll
              for (int bj = 0; bj < 2; ++bj)
#pragma unroll
                  for (int n = 0; n < 2; ++n) *(f32x4*)(uht + (fr - 12) * UWc + bj * 128 + 4 * n) = acc[1][bj][3][n]; } }
        asm volatile("s_waitcnt lgkmcnt(0)" ::: "memory"); __builtin_amdgcn_s_barrier(); asm volatile("" ::: "memory");
        const bool seq0 = ((u.pm * BM) & 4095) == 0;
#pragma unroll
        for (int n = 0; n < 2; ++n) {
            f32x4 wgt[3][2], bia[2];
#pragma unroll
            for (int bj = 0; bj < 2; ++bj) { bia[bj] = *(const f32x4*)(cb + bj * FF + ch0 + 4 * n);
#pragma unroll
                for (int i = 0; i < 3; ++i) wgt[i][bj] = *(const f32x4*)(cw + i * UWc + bj * FF + ch0 + 4 * n); }
#pragma unroll
            for (int ai = 0; ai < 2; ++ai) {
                const int bi = 2 * ai + wr;
                f32x4 prev[2];
#pragma unroll
                for (int bj = 0; bj < 2; ++bj) { const f32x4 v = *(const PG8_LAS f32x4*)(xch + ((bi > 0 ? bi - 1 : 0) * 2 + (fr & 1)) * 256 + bj * 128 + chl + 4 * n);
                    prev[bj] = bi > 0 ? v : (f32x4){0.f, 0.f, 0.f, 0.f}; }
#pragma unroll
                for (int m = 0; m < 4; ++m) {
                    float o[4];
#pragma unroll
                    for (int e = 0; e < 4; ++e) {
                        const float gc = acc[ai][0][m][n][e], gp = prev[0][e]; const float g1 = dpp_shr1(dpp_ror1(gp), gc), g2 = dpp_shr2(dpp_ror2(gp), gc);
                        const float uc = acc[ai][1][m][n][e], up = prev[1][e]; const float u1 = dpp_shr1(dpp_ror1(up), uc), u2 = dpp_shr2(dpp_ror2(up), uc);
                        const float gv = bia[0][e] + wgt[0][0][e] * g2 + wgt[1][0][e] * g1 + wgt[2][0][e] * gc;
                        const float uv = bia[1][e] + wgt[0][1][e] * u2 + wgt[1][1][e] * u1 + wgt[2][1][e] * uc;
                        o[e] = gv * __builtin_amdgcn_rcpf(1.0f + __builtin_amdgcn_exp2f(-1.4426950408889634f * gv)) * uv; }
                    prev[0] = acc[ai][0][m][n]; prev[1] = acc[ai][1][m][n];
                    const int row = u.pm * BM + ai * HALF + wr * 64 + m * 16 + fr;
                    if (!(bi == 0 && m == 0 && fr < 2 && !seq0)) { u32x2 w; w.x = cvt_pk_bf16(o[0], o[1]); w.y = cvt_pk_bf16(o[2], o[3]); *(u32x2*)(act + (size_t)row * FF + ch0 + 4 * n) = w; }
                }
            }
        }
    }
};
template <class Epi, class Sched, bool ALIGN_EPI = false, bool SP2 = false>
__device__ __forceinline__ void gemm_phase(PG8_LAS unsigned char* lds, const Gemm g, const Sched& S, const Epi& E, int tid_in) {
    int tid_o = tid_in; asm volatile("" : "+v"(tid_o));
    const int tid = tid_o, wid = __builtin_amdgcn_readfirstlane(tid >> 6), lane = tid & 63, wr = wid >> 2, wc = wid & 3, fr = lane & 15, fq = lane >> 4;
    const int K = g.K, nt = K / BK;
    unsigned voffA[2], voffB[2];
#pragma unroll
    for (int i = 0; i < 2; ++i) { int R, C; stage_rc(tid * 16 + i * 8192, R, C); const int Rb = Epi::PERM ? ((R & ~31) + perm32(R & 31)) : R;
        voffA[i] = (unsigned)(R * K + C) * 2u; voffB[i] = (unsigned)(Rb * K + C) * 2u; }
    const size_t kstep = (size_t)(BK * 2);
    const size_t hstep = (size_t)HALF * K * 2;
    const size_t tstep = 2 * hstep;
    const unsigned ldsw = (unsigned)wid * 1024u;
    const int aoff = lds_byte(wr * 64 + fr, fq * 8), boff = lds_byte(wc * 32 + fr, fq * 8);
#define PG8_SA(b, h) (((b) * 2 + (h)) * HTB)
#define PG8_SB(b, h) ((4 + (b) * 2 + (h)) * HTB)
#define PG8_STAGE(bufoff, gbase, voff) do { _Pragma("unroll") for (int _i = 0; _i < 2; ++_i) \
        __builtin_amdgcn_global_load_lds((const unsigned*)((const char*)(gbase) + (voff)[_i]), (PG8_LAS unsigned*)(lds + (bufoff) + ldsw + _i * 8192), 16, 0, 0); } while (0)
#define PG8_LDA(dst, b, h) do { _Pragma("unroll") for (int m = 0; m < 4; ++m) _Pragma("unroll") for (int k = 0; k < 2; ++k) dst[m][k] = *(const PG8_LAS bf16x8*)(lds + PG8_SA(b, h) + aoff + m * 2048 + k * 1024); } while (0)
#define PG8_LDB(dst, b, h) do { _Pragma("unroll") for (int n = 0; n < 2; ++n) _Pragma("unroll") for (int k = 0; k < 2; ++k) dst[n][k] = *(const PG8_LAS bf16x8*)(lds + PG8_SB(b, h) + boff + n * 2048 + k * 1024); } while (0)
#define PG8_MMA(ai, bj, At, Bt) do { __builtin_amdgcn_s_setprio(1); _Pragma("unroll") for (int m = 0; m < 4; ++m) _Pragma("unroll") for (int n = 0; n < 2; ++n) _Pragma("unroll") for (int k = 0; k < 2; ++k) \
        acc[ai][bj][m][n] = __builtin_amdgcn_mfma_f32_16x16x32_bf16(Bt[n][k], At[m][k], acc[ai][bj][m][n], 0, 0, 0); __builtin_amdgcn_s_setprio(0); } while (0)
#define PG8_WAIT_V(n) asm volatile("s_waitcnt vmcnt(" #n ")" ::: "memory")
#define PG8_WAIT_L(n) asm volatile("s_waitcnt lgkmcnt(" #n ")" ::: "memory")
#define PG8_BAR __builtin_amdgcn_s_barrier()
#define PG8_SCHED __builtin_amdgcn_sched_barrier(0)
    Unit cur, nxt; int ui = 0;
    if (!S.next(0, cur)) return;
    f32x4 acc[2][2][4][2];
#pragma unroll
    for (int a = 0; a < 2; ++a)
#pragma unroll
        for (int b = 0; b < 2; ++b)
#pragma unroll
            for (int m = 0; m < 4; ++m)
#pragma unroll
                for (int n = 0; n < 2; ++n) acc[a][b][m][n] = (f32x4){0.f, 0.f, 0.f, 0.f};
    bf16x8 At[4][2], B0[2][2], B1[2][2];
    const char* cA = (const char*)g.A + (size_t)cur.pm * tstep; const char* cB = (const char*)g.Bt + (size_t)cur.pn * tstep;
    S.a_ready(cur);
    if constexpr (SP2) {
        PG8_STAGE(PG8_SB(0, 0), cB, voffB); PG8_STAGE(PG8_SB(0, 1), cB + hstep, voffB); PG8_STAGE(PG8_SA(0, 0), cA, voffA); PG8_STAGE(PG8_SA(0, 1), cA + hstep, voffA);
        if (wr == 1) PG8_BAR;
        PG8_WAIT_V(2); PG8_BAR;
        PG8_STAGE(PG8_SB(1, 0), cB + kstep, voffB); PG8_STAGE(PG8_SA(1, 0), cA + kstep, voffA); PG8_STAGE(PG8_SB(1, 1), cB + hstep + kstep, voffB);
        PG8_WAIT_V(6); PG8_BAR;
    } else {
        PG8_STAGE(PG8_SB(0, 0), cB, voffB); PG8_STAGE(PG8_SA(0, 0), cA, voffA); PG8_STAGE(PG8_SB(0, 1), cB + hstep, voffB); PG8_STAGE(PG8_SA(0, 1), cA + hstep, voffA);
        if (wr == 1) PG8_BAR;
        PG8_WAIT_V(4); PG8_BAR;
        PG8_STAGE(PG8_SB(1, 0), cB + kstep, voffB); PG8_STAGE(PG8_SA(1, 0), cA + kstep, voffA); PG8_STAGE(PG8_SB(1, 1), cB + hstep + kstep, voffB);
        PG8_WAIT_V(6); PG8_BAR;
    }
    for (;;) {
        const bool has_next = S.next(ui + 1, nxt);
        const char* nA = has_next ? (const char*)g.A + (size_t)nxt.pm * tstep : cA; const char* nB = has_next ? (const char*)g.Bt + (size_t)nxt.pn * tstep : cB;
        for (int t = 0; t < nt; t += 2) {
            const bool last = (t == nt - 2);
            const char* a1 = cA + (size_t)(t + 1) * kstep;
            const char* a2 = last ? nA : cA + (size_t)(t + 2) * kstep; const char* b2 = last ? nB : cB + (size_t)(t + 2) * kstep;
            const char* a3 = a2 + kstep; const char* b3 = b2 + kstep;
            if (last && has_next) S.a_ready(nxt);
            if constexpr (SP2) {
            PG8_LDB(B0, 0, 0); PG8_LDB(B1, 0, 1); PG8_SCHED; PG8_LDA(At, 0, 0); PG8_STAGE(PG8_SA(1, 1), a1 + hstep, voffA);
            PG8_WAIT_V(8); PG8_WAIT_L(0); PG8_BAR; PG8_MMA(0, 0, At, B0); PG8_MMA(0, 1, At, B1); PG8_BAR; PG8_SCHED;
            PG8_LDA(At, 0, 1); PG8_STAGE(PG8_SB(0, 0), b2, voffB); PG8_STAGE(PG8_SB(0, 1), b2 + hstep, voffB); PG8_STAGE(PG8_SA(0, 0), a2, voffA);
            PG8_WAIT_V(8); PG8_WAIT_L(0); PG8_BAR; PG8_MMA(1, 0, At, B0); PG8_MMA(1, 1, At, B1); PG8_BAR; PG8_SCHED;
            PG8_LDB(B0, 1, 0); PG8_LDB(B1, 1, 1); PG8_SCHED; PG8_LDA(At, 1, 0); PG8_STAGE(PG8_SA(0, 1), a2 + hstep, voffA);
            PG8_WAIT_V(8); PG8_WAIT_L(0); PG8_BAR; PG8_MMA(0, 0, At, B0); PG8_MMA(0, 1, At, B1); PG8_BAR; PG8_SCHED;
            PG8_LDA(At, 1, 1); PG8_STAGE(PG8_SB(1, 0), b3, voffB); PG8_STAGE(PG8_SB(1, 1), b3 + hstep, voffB); PG8_STAGE(PG8_SA(1, 0), a3, voffA);
            PG8_WAIT_V(8); PG8_WAIT_L(0); PG8_BAR; PG8_MMA(1, 0, At, B0); PG8_MMA(1, 1, At, B1); PG8_BAR; PG8_SCHED;
            } else {
            PG8_LDB(B0, 0, 0); PG8_SCHED; PG8_LDA(At, 0, 0); PG8_STAGE(PG8_SA(1, 1), a1 + hstep, voffA);
            PG8_WAIT_L(8); PG8_BAR; PG8_WAIT_L(0); PG8_MMA(0, 0, At, B0); PG8_BAR; PG8_SCHED;
            PG8_LDB(B1, 0, 1); PG8_STAGE(PG8_SB(0, 0), b2, voffB);
            PG8_BAR; PG8_WAIT_L(0); PG8_MMA(0, 1, At, B1); PG8_BAR;
            PG8_LDA(At, 0, 1); PG8_STAGE(PG8_SA(0, 0), a2, voffA);
            PG8_BAR; PG8_WAIT_L(0); PG8_MMA(1, 0, At, B0); PG8_BAR; PG8_SCHED;
            PG8_STAGE(PG8_SB(0, 1), b2 + hstep, voffB);
            PG8_WAIT_V(6); PG8_BAR; PG8_MMA(1, 1, At, B1); PG8_BAR;
            PG8_LDB(B0, 1, 0); PG8_SCHED; PG8_LDA(At, 1, 0); PG8_STAGE(PG8_SA(0, 1), a2 + hstep, voffA);
            PG8_WAIT_L(8); PG8_BAR; PG8_WAIT_L(0); PG8_MMA(0, 0, At, B0); PG8_BAR; PG8_SCHED;
            PG8_LDB(B1, 1, 1); PG8_STAGE(PG8_SB(1, 0), b3, voffB);
            PG8_BAR; PG8_WAIT_L(0); PG8_MMA(0, 1, At, B1); PG8_BAR;
            PG8_LDA(At, 1, 1); PG8_STAGE(PG8_SA(1, 0), a3, voffA);
            PG8_BAR; PG8_WAIT_L(0); PG8_MMA(1, 0, At, B0); PG8_BAR; PG8_SCHED;
            PG8_STAGE(PG8_SB(1, 1), b3 + hstep, voffB);
            PG8_WAIT_V(6); PG8_BAR; PG8_MMA(1, 1, At, B1); PG8_BAR;
            }
        }
        if constexpr (ALIGN_EPI) { if (wr == 0) PG8_BAR; }
        if constexpr (!Epi::AFTER_DRAIN) { E(acc, cur, wr, wc, fr, fq); S.done(cur); }
        if (!has_next) break;
#pragma unroll
        for (int a = 0; a < 2; ++a)
#pragma unroll
            for (int b = 0; b < 2; ++b)
#pragma unroll
                for (int m = 0; m < 4; ++m)
#pragma unroll
                    for (int n = 0; n < 2; ++n) acc[a][b][m][n] = (f32x4){0.f, 0.f, 0.f, 0.f};
        cur = nxt; cA = nA; cB = nB; ++ui;
        if constexpr (ALIGN_EPI) { if (wr == 1) PG8_BAR; }
    }
    PG8_WAIT_V(0);
    if constexpr (!ALIGN_EPI) { if (wr == 0) PG8_BAR; }
    PG8_BAR;
    if constexpr (Epi::AFTER_DRAIN) { E.fused(acc, cur, wr, wc, fr, fq, lds, wid, lane); S.done(cur); }
#undef PG8_SA
#undef PG8_SB
#undef PG8_STAGE
#undef PG8_LDA
#undef PG8_LDB
#undef PG8_MMA
#undef PG8_WAIT_V
#undef PG8_WAIT_L
#undef PG8_BAR
#undef PG8_SCHED
}
}
constexpr int NB = 8, SEQ = 4096, DM = 2048, DEPTH = 4, MTOK = NB * SEQ;
constexpr int PW = 5376, DFF = 5632, UW = 2 * DFF, ATW = 4096, NBUCK = 32;
constexpr int PC_AQ = 0, PC_AK = 512, PC_AV = 640, PC_BQ = 768, PC_BK = 1280, PC_BV = 1792, PC_CQ = 2304, PC_CK = 3328, PC_CV = 4352;
constexpr int AT_A = 0, AT_B = 512, AT_C = 1024;
constexpr float EPS = 1e-6f;
constexpr size_t MiB = 1u << 20;
constexpr size_t WS_R1_ = 456 * MiB;
constexpr size_t WS_WIN = 0, WS_WOUT = 21 * MiB, WS_WUP = 29 * MiB, WS_WDOWN = 73 * MiB, WS_LSE = 96 * MiB;
constexpr size_t WS_BIAS = 102 * MiB, WS_GQK = 102 * MiB + 65536;
constexpr size_t WS_XB2 = WS_R1_ + 352 * MiB;
constexpr size_t WS_MIX = 104 * MiB + 128 * MiB;
constexpr size_t WS_CTL = 103 * MiB;
constexpr size_t WS_R2 = 104 * MiB;
constexpr size_t WS_R1 = 456 * MiB;
constexpr size_t WS_ATT = WS_R1 + 336 * MiB;
constexpr size_t WS_UH = WS_R1 + 704 * MiB;
constexpr size_t WS_RS1 = WS_UH + 24 * MiB, WS_RS2 = WS_RS1 + 4 * MiB;
constexpr size_t WS_RSTD1 = WS_RS2 + 4 * MiB, WS_RSTD2 = WS_RSTD1 + 131072;
constexpr size_t WS_END = WS_RSTD1 + 1 * MiB;
constexpr int LDS_XCH = 131072 + 64;
constexpr int LDS_BYTES = 131072 + 64 + 8192;
constexpr int NWAVES = 8;

#define GAS __attribute__((address_space(1)))
#define LAS __attribute__((address_space(3)))
typedef unsigned short bf16;
typedef unsigned v4u __attribute__((ext_vector_type(4)));
typedef float f32x4 __attribute__((ext_vector_type(4)));
#define LDS_WAIT() asm volatile("s_waitcnt lgkmcnt(0)" ::: "memory")
__device__ __forceinline__ unsigned f2bf(float f) { unsigned u = __builtin_bit_cast(unsigned, f); return (u + 0x7fffu + ((u >> 16) & 1u)) >> 16; }
typedef float f32x2_t __attribute__((ext_vector_type(2))); typedef __bf16 bf16x2_t __attribute__((ext_vector_type(2)));
__device__ __forceinline__ unsigned pk2(float lo, float hi) { const f32x2_t v = {lo, hi}; const bf16x2_t b = __builtin_convertvector(v, bf16x2_t); return __builtin_bit_cast(unsigned, b); }
__device__ __forceinline__ float bflo(unsigned w) { return __uint_as_float(w << 16); }
__device__ __forceinline__ float bfhi(unsigned w) { return __uint_as_float(w & 0xffff0000u); }
__device__ __forceinline__ float wave_sum(float v) {
#pragma unroll
    for (int o = 1; o < 64; o <<= 1) v += __shfl_xor(v, o);
    return v;
}
#define DPP_F(v, CTRL) __int_as_float(__builtin_amdgcn_mov_dpp(__float_as_int(v), (CTRL), 0xf, 0xf, false))
__device__ __forceinline__ float red8_dpp(float v) { v += DPP_F(v, 0xB1); v += DPP_F(v, 0x4E); v += DPP_F(v, 0x141); return v; }
__device__ __forceinline__ float sum_halves(float v) { const auto rr = __builtin_amdgcn_permlane32_swap(__float_as_uint(v), __float_as_uint(v), false, false); return __uint_as_float(rr[0]) + __uint_as_float(rr[1]); }
#define UNPACK8(wv_, f) do { const v4u w_ = (wv_); f[0] = bflo(w_.x); f[1] = bfhi(w_.x); f[2] = bflo(w_.y); f[3] = bfhi(w_.y); f[4] = bflo(w_.z); f[5] = bfhi(w_.z); f[6] = bflo(w_.w); f[7] = bfhi(w_.w); } while (0)

#define RLX_AGENT __ATOMIC_RELAXED, __HIP_MEMORY_SCOPE_AGENT
#define XB_TMO      128
#define XB_XCNT(j)  (256  + 64 * (j))
#define XB_XSUB(j)  (1280 + 64 * (j))
#define XB_XGEN(j)  (2304 + 64 * (j))
#define XB_TOP      3328
#define XB_TOPGEN   3392
#define XCD_BAR_WORDS 3456
#define XB_SPIN_CAP (1u << 18)

__device__ __forceinline__ unsigned xb_ld(unsigned* p)              { return __hip_atomic_load(p, __ATOMIC_RELAXED, __HIP_MEMORY_SCOPE_AGENT); }
__device__ __forceinline__ unsigned xb_add(unsigned* p, unsigned v) { return __hip_atomic_fetch_add(p, v, __ATOMIC_RELAXED, __HIP_MEMORY_SCOPE_AGENT); }
__device__ __forceinline__ unsigned xb_xcc_id() { return (unsigned)__builtin_amdgcn_s_getreg((3 << 11) | 20) & 0xFu; }
#define XB_SPIN(cond, bar) do { unsigned _sp = 0; while (cond) { __builtin_amdgcn_s_sleep(1); \
    if ((++_sp & 255u) == 0u) { if (xb_ld(&(bar)[XB_TMO])) break; if (_sp > XB_SPIN_CAP) { atomicAdd(&(bar)[XB_TMO], 1u); break; } } } } while (0)

struct XcdBarrier {
    unsigned* bar; unsigned x;
    volatile LAS unsigned* st;
};

__device__ __forceinline__ XcdBarrier xcd_barrier_post(unsigned* bar, volatile LAS unsigned* st) {
    XcdBarrier b; b.bar = bar; b.x = xb_xcc_id(); b.st = st;
    if (threadIdx.x == 0) (void)xb_add(&bar[XB_XCNT(b.x)], 1u);
    return b;
}
__device__ __forceinline__ void xcd_barrier_complete(unsigned* bar, unsigned x, unsigned& nloc, unsigned& nx) {
    const unsigned G = gridDim.x * gridDim.y * gridDim.z;
    unsigned sum, cnt, mine, sp = 0u;
    for (;;) {
        sum = 0u; cnt = 0u; mine = 0u;
#pragma unroll
        for (unsigned j = 0; j < 16; ++j) { const unsigned c = xb_ld(&bar[XB_XCNT(j)]); sum += c; cnt += (c > 0u) ? 1u : 0u; mine = (j == x) ? c : mine; }
        if (sum == G) break;
        __builtin_amdgcn_s_sleep(1);
        if ((++sp & 255u) == 0u) { if (xb_ld(&bar[XB_TMO])) break; if (sp > XB_SPIN_CAP) { atomicAdd(&bar[XB_TMO], 1u); break; } }
    }
    nloc = mine > 0u ? mine : 1u; nx = cnt > 0u ? cnt : 1u;
}

__device__ __forceinline__ void xcd_barrier(const XcdBarrier& b, int wave_) {
    unsigned lzb_ = 0u; asm volatile("" : "+v"(lzb_)); const bool leader_ = (wave_ == 0) && (__builtin_amdgcn_mbcnt_hi(~0u, __builtin_amdgcn_mbcnt_lo(~0u, lzb_)) == 0u);
    asm volatile("s_waitcnt vmcnt(0)" ::: "memory");
    __syncthreads();
    if (leader_) {
        unsigned* bar = b.bar;
        __builtin_amdgcn_s_waitcnt(0);
        unsigned nloc = b.st[0], nx = b.st[1];
        if (nloc == 0u) { xcd_barrier_complete(bar, b.x, nloc, nx); b.st[0] = nloc; b.st[1] = nx; }
        const unsigned old = xb_add(&bar[XB_XSUB(b.x)], 1u);
        const unsigned gen = old / nloc;
        if (old + 1u == (gen + 1u) * nloc) {
            __builtin_amdgcn_fence(__ATOMIC_RELEASE, "agent");
            asm volatile("s_waitcnt vmcnt(0)" ::: "memory");
            const unsigned og = xb_add(&bar[XB_TOP], 1u);
            const unsigned tg = og / nx;
            if (og + 1u == (tg + 1u) * nx) xb_add(&bar[XB_TOPGEN], 1u);
            else XB_SPIN(xb_ld(&bar[XB_TOPGEN]) == tg, bar);
            __builtin_amdgcn_fence(__ATOMIC_ACQUIRE, "agent");
            xb_add(&bar[XB_XGEN(b.x)], 1u);
            asm volatile("s_waitcnt vmcnt(0)" ::: "memory");
        } else {
            XB_SPIN(xb_ld(&bar[XB_XGEN(b.x)]) == gen, bar);
            __builtin_amdgcn_fence(__ATOMIC_ACQUIRE, "agent");
            asm volatile("s_waitcnt vmcnt(0)" ::: "memory");
        }
    }
    __syncthreads();
}
typedef short bf16x8 __attribute__((ext_vector_type(8)));
typedef short s16x4 __attribute__((ext_vector_type(4)));
typedef float f32x16 __attribute__((ext_vector_type(16)));
typedef unsigned u32x2v __attribute__((ext_vector_type(2)));
#define MFMA32(a, b, c) __builtin_amdgcn_mfma_f32_32x32x16_bf16((a), (b), (c), 0, 0, 0)
constexpr int KP = 144;
constexpr float LOG2E = 1.4426950408889634f, LN2 = 0.6931471805599453f;
typedef __bf16 bf16x2_dt __attribute__((ext_vector_type(2)));
__device__ __forceinline__ float sumsq8(const v4u& w, float acc) {
    float f[8]; UNPACK8(w, f);
#pragma unroll
    for (int e = 0; e < 8; ++e) acc += f[e] * f[e];
    return acc;
}
__device__ __forceinline__ int kvperm(int rho) { return 16 * ((rho >> 2) & 1) + (rho & 3) + 4 * (rho >> 3); }
__device__ __forceinline__ s16x4 trrd(const LAS unsigned char* p) { typedef short v4i16_t __attribute__((ext_vector_type(4))); return __builtin_bit_cast(s16x4, __builtin_amdgcn_ds_read_tr16_b64_v4i16((LAS v4i16_t*)p)); }
__device__ __forceinline__ bf16x8 vfrag(const LAS unsigned char* p) { const s16x4 lo = trrd(p), hi = trrd(p + 4 * KP); return (bf16x8){lo[0], lo[1], lo[2], lo[3], hi[0], hi[1], hi[2], hi[3]}; }
__device__ __forceinline__ bf16x8 pack8(const f32x16& x, int s) {
    v4u p; p.x = pk2(x[8 * s], x[8 * s + 1]); p.y = pk2(x[8 * s + 2], x[8 * s + 3]); p.z = pk2(x[8 * s + 4], x[8 * s + 5]); p.w = pk2(x[8 * s + 6], x[8 * s + 7]);
    return __builtin_bit_cast(bf16x8, p);
}
__device__ __forceinline__ void store_ot(bf16* orow, const f32x16 (&o)[2], float sc, int h) {
#pragma unroll
    for (int db = 0; db < 2; ++db)
#pragma unroll
        for (int p = 0; p < 2; ++p) { const int g0 = 2 * p, g1 = 2 * p + 1;
            const unsigned a0 = pk2(o[db][4 * g0] * sc, o[db][4 * g0 + 1] * sc), a1 = pk2(o[db][4 * g0 + 2] * sc, o[db][4 * g0 + 3] * sc);
            const unsigned b0 = pk2(o[db][4 * g1] * sc, o[db][4 * g1 + 1] * sc), b1 = pk2(o[db][4 * g1 + 2] * sc, o[db][4 * g1 + 3] * sc);
            const auto rx = __builtin_amdgcn_permlane32_swap(a0, b0, false, false), ry = __builtin_amdgcn_permlane32_swap(a1, b1, false, false);
            v4u w; w.x = rx[0]; w.y = ry[0]; w.z = rx[1]; w.w = ry[1];
            *(v4u*)(orow + 32 * db + 16 * p + 8 * h) = w; }
}
struct BandCfg { const bf16* qg; const bf16* kg; const bf16* vg; size_t rstride; int q0; int maxd; const float* bias2; int gqk; float sink2; bf16* og; size_t ostride; float* lseg; size_t lstride; };
__device__ __forceinline__ BandCfg band_cfg(int u, const bf16* PROJ, bf16* ATT, float* LSE, const float* B2, const float* GQ, const float* a_sinks) {
    BandCfg c;
    if (u < 2048) { const int v = u - 1024, b = 7 - (v >> 7), hh = (v >> 4) & 7, qb = v & 15;     const bf16* pb = PROJ + (size_t)b * 84 * SEQ * 64;
        c.qg = pb + (size_t)hh * SEQ * 64; c.kg = pb + (size_t)(8 + (hh >> 2)) * SEQ * 64; c.vg = pb + (size_t)(10 + (hh >> 2)) * SEQ * 64; c.rstride = 64; c.q0 = qb * 256; c.maxd = 127;
        c.bias2 = B2 + hh * 160; c.gqk = 0; c.sink2 = a_sinks[hh] * LOG2E; c.og = ATT + ((size_t)b * 64 + hh) * SEQ * 64; c.ostride = 64; c.lseg = nullptr; c.lstride = 0; }
    else { const int v = u - 2048, g = v / 48, rem = v - 48 * g, br = rem >> 4, k = rem & 15, b = 7 - (g >> 4), hh = g & 15;     const int dil = 1 << (2 * br), sub = k & (dil - 1), blk = k >> (2 * br);
        const bf16* pb = PROJ + ((size_t)b * 84 * SEQ + sub) * 64;
        c.qg = pb + (size_t)(36 + hh) * SEQ * 64; c.kg = pb + (size_t)(52 + hh) * SEQ * 64; c.vg = pb + (size_t)(68 + hh) * SEQ * 64; c.rstride = (size_t)dil * 64; c.q0 = blk * 256; c.maxd = 128;
        c.bias2 = B2 + ((1 + br) * 16 + hh) * 160; c.gqk = 64; c.sink2 = -1e30f; c.og = ATT + (((size_t)b * 64 + 16 + 16 * br + hh) * SEQ + sub) * 64; c.ostride = (size_t)dil * 64;
        c.lseg = LSE + ((size_t)br * MTOK + (size_t)b * SEQ + sub) * 16 + hh; c.lstride = (size_t)dil * 16; }
    return c;
}
__device__ __forceinline__ void band_fetch(const BandCfg& c, int tid, v4u (&kr)[6], v4u (&vr)[6], float& bv, v4u (&qw)[4]) {
    { const int ln = tid & 63, wv = tid >> 6, qpos = c.q0 + 32 * wv + (ln & 31);
#pragma unroll
      for (int ds = 0; ds < 4; ++ds) qw[ds] = *(const v4u*)(c.qg + (size_t)qpos * c.rstride + 16 * ds + 8 * (ln >> 5)); }
#pragma unroll
    for (int p = 0; p < 6; ++p) { const int row = p * 64 + (tid >> 3), cc = tid & 7, pos = c.q0 - 128 + row;
        kr[p] = (v4u){0u, 0u, 0u, 0u}; vr[p] = (v4u){0u, 0u, 0u, 0u};
        if (pos >= 0) { kr[p] = *(const v4u*)(c.kg + (size_t)pos * c.rstride + 8 * cc); vr[p] = *(const v4u*)(c.vg + (size_t)pos * c.rstride + 8 * cc); } }
    bv = 0.f; if (tid < 192) { const int j = 159 - tid; if (j >= 0) bv = c.bias2[j]; }
}
__device__ __forceinline__ void banded_unit(LAS unsigned char* lds, const BandCfg& c, int tid_, int lane_, int wave, v4u (&kr)[6], v4u (&vr)[6], float& bv, v4u (&qw)[4], const LAS float* gqkL, bool has_next, int un, BandCfg& cn, const bf16* PROJ, bf16* ATT, float* LSE, const float* B2, const float* a_sinks) {
    int lane = lane_; asm volatile("" : "+v"(lane)); const int tid = wave * 64 + lane; (void)tid_;
    LAS unsigned char* Kl = lds; LAS unsigned char* Vl = lds + 384 * KP; LAS float* rkL = (LAS float*)(lds + 2 * 384 * KP); LAS float* revL = rkL + 384;
    const int q0 = c.q0;
    __syncthreads();
#pragma unroll
    for (int p = 0; p < 6; ++p) { const int row = p * 64 + (tid >> 3), cc = tid & 7;
        *(LAS v4u*)(Kl + row * KP + 16 * cc) = kr[p]; *(LAS v4u*)(Vl + row * KP + 16 * cc) = vr[p]; }
    if (tid < 192) revL[tid] = bv;
    const int r = lane & 31, h = lane >> 5, qpos = q0 + 32 * wave + r;
    bf16x8 qf[4];
#pragma unroll
    for (int ds = 0; ds < 4; ++ds) qf[ds] = __builtin_bit_cast(bf16x8, qw[ds]);
    __syncthreads();
    if (has_next) { cn = band_cfg(un, PROJ, ATT, LSE, B2, nullptr, a_sinks); band_fetch(cn, tid, kr, vr, bv, qw); }
    f32x16 S[5];
#define SCHED_FENCE() __builtin_amdgcn_sched_barrier(0)
    {
        const LAS unsigned char* ka = Kl + (32 * wave + kvperm(r)) * KP + 16 * h;
        bf16x8 kf[2][4];
#pragma unroll
        for (int ds = 0; ds < 4; ++ds) kf[0][ds] = *(const LAS bf16x8*)(ka + ds * 32);
#pragma unroll
        for (int T = 0; T < 5; ++T) {
            if (T < 4) {
#pragma unroll
                for (int ds = 0; ds < 4; ++ds) kf[(T + 1) & 1][ds] = *(const LAS bf16x8*)(ka + (T + 1) * 32 * KP + ds * 32); }
            SCHED_FENCE();
            f32x16 acc;
#pragma unroll
            for (int i = 0; i < 16; ++i) acc[i] = 0.f;
#pragma unroll
            for (int ds = 0; ds < 4; ++ds) acc = MFMA32(kf[T & 1][ds], qf[ds], acc);
            S[T] = acc;
            SCHED_FENCE();
        }
    }
    float l = 0.f;
    {
        const int kbase = q0 + 32 * wave - 128, brel = 128 + r - 16 * h;
        int lo = brel - c.maxd; { const int l2 = -kbase - 16 * h; lo = lo > l2 ? lo : l2; }
        const unsigned span = (unsigned)(brel - lo); const int nlo = -lo;
        const LAS float* bp = revL + (159 - brel);
        float bb[1][16];
#define BAND_LOAD(T, B) _Pragma("unroll") for (int i = 0; i < 16; ++i) bb[B][i] = bp[32 * (T) + i];
#define BAND_TILE_MASKED(T, B) _Pragma("unroll") for (int i = 0; i < 16; ++i) { const int x = 32 * (T) + i; const bool ok = (unsigned)(x + nlo) <= span; \
                const float sv = S[T][i] + bb[B][i]; const float p = __builtin_amdgcn_exp2f(ok ? sv : -1e30f); S[T][i] = p; l += p; }
#define BAND_TILE_FREE(T, B) _Pragma("unroll") for (int i = 0; i < 16; ++i) { const float p = __builtin_amdgcn_exp2f(S[T][i] + bb[B][i]); S[T][i] = p; l += p; }
        if (kbase >= 0) {
            BAND_LOAD(0, 0) SCHED_FENCE(); BAND_TILE_MASKED(0, 0) SCHED_FENCE();
            BAND_LOAD(1, 0) SCHED_FENCE(); BAND_TILE_FREE(1, 0) SCHED_FENCE();
            BAND_LOAD(2, 0) SCHED_FENCE(); BAND_TILE_FREE(2, 0) SCHED_FENCE();
            BAND_LOAD(3, 0) SCHED_FENCE(); BAND_TILE_FREE(3, 0) SCHED_FENCE();
            BAND_LOAD(4, 0) SCHED_FENCE(); BAND_TILE_MASKED(4, 0)
        } else {
            BAND_LOAD(0, 0) SCHED_FENCE(); BAND_TILE_MASKED(0, 0) SCHED_FENCE();
            BAND_LOAD(1, 0) SCHED_FENCE(); BAND_TILE_MASKED(1, 0) SCHED_FENCE();
            BAND_LOAD(2, 0) SCHED_FENCE(); BAND_TILE_MASKED(2, 0) SCHED_FENCE();
            BAND_LOAD(3, 0) SCHED_FENCE(); BAND_TILE_MASKED(3, 0) SCHED_FENCE();
            BAND_LOAD(4, 0) SCHED_FENCE(); BAND_TILE_MASKED(4, 0)
        }
#undef BAND_LOAD
#undef BAND_TILE_MASKED
#undef BAND_TILE_FREE
    }
    l = sum_halves(l); l += __builtin_amdgcn_exp2f(c.sink2);
    const float m = 0.f;
    f32x16 o[2];
#pragma unroll
    for (int i = 0; i < 16; ++i) { o[0][i] = 0.f; o[1][i] = 0.f; }
    {
        const LAS unsigned char* va = Vl + (32 * wave + 16 * h + ((lane & 15) >> 2)) * KP + ((lane >> 4) & 1) * 32 + (lane & 3) * 8;
        bf16x8 vf[2][2];
        vf[0][0] = vfrag(va); vf[0][1] = vfrag(va + 64);
#pragma unroll
        for (int j = 0; j < 10; ++j) { const int T = j >> 1, sx = j & 1;
            if (j < 9) { const int Tn = (j + 1) >> 1, sn = (j + 1) & 1; vf[(j + 1) & 1][0] = vfrag(va + (32 * Tn + 8 * sn) * KP); vf[(j + 1) & 1][1] = vfrag(va + (32 * Tn + 8 * sn) * KP + 64); }
            SCHED_FENCE();
            const bf16x8 pf = pack8(S[T], sx);
            o[0] = MFMA32(vf[j & 1][0], pf, o[0]); o[1] = MFMA32(vf[j & 1][1], pf, o[1]);
            SCHED_FENCE();
        }
    }
#undef SCHED_FENCE
    store_ot(c.og + (size_t)qpos * c.ostride, o, __builtin_amdgcn_rcpf(l), h);
    if (c.lseg && h == 0) c.lseg[(size_t)qpos * c.lstride] = (m + __builtin_amdgcn_logf(l)) * LN2;
}
__device__ __forceinline__ void sb_tile(const LAS unsigned char* kat, const LAS unsigned char* vat, bool diag, int r, int h, const bf16x8 (&qf)[4], float& R, f32x16 (&o)[2]) {
    f32x16 z;
#pragma unroll
    for (int i = 0; i < 16; ++i) z[i] = 0.f;
    bf16x8 kf[4], vfr[2][2];
#pragma unroll
    for (int ds = 0; ds < 4; ++ds) kf[ds] = *(const LAS bf16x8*)(kat + ds * 32);
#pragma unroll
    for (int s = 0; s < 2; ++s)
#pragma unroll
        for (int db = 0; db < 2; ++db) vfr[s][db] = vfrag(vat + (8 * s) * KP + db * 64);
    __builtin_amdgcn_sched_barrier(0);
#pragma unroll
    for (int ds = 0; ds < 4; ++ds) z = MFMA32(kf[ds], qf[ds], z);
    float cs[17]; float run = 1.f; cs[16] = 1.f;
#pragma unroll
    for (int i = 15; i >= 0; --i) { const bool ok = !diag || (16 * h + i < r);
        const float e = __builtin_amdgcn_exp2f(fminf(z[i] * LOG2E, 80.0f)); const float rm = __builtin_amdgcn_rcpf(1.0f + e);
        z[i] = ok ? e * rm : 0.f; run *= ok ? rm : 1.0f; cs[i] = run; }
    float tot_o; { const auto rr = __builtin_amdgcn_permlane32_swap(__float_as_uint(run), __float_as_uint(run), false, false); tot_o = __uint_as_float(h == 0 ? rr[1] : rr[0]); }
    const float base = R * (h == 0 ? tot_o : 1.0f);
#pragma unroll
    for (int i = 0; i < 16; ++i) z[i] = z[i] * (base * cs[i + 1]);
    R *= run * tot_o;
#pragma unroll
    for (int s = 0; s < 2; ++s) { const bf16x8 pf = pack8(z, s);
#pragma unroll
        for (int db = 0; db < 2; ++db) o[db] = MFMA32(vfr[s][db], pf, o[db]); }
}
__device__ __forceinline__ void sb_fetch(const bf16* qg, const bf16* kg, const bf16* vg, int q0, int tid, v4u (&k6)[6], v4u (&v6)[6], v4u (&qw)[4]) {
    const int srow = tid >> 3, scc = tid & 7, ln = tid & 63, qpos = q0 + 32 * (tid >> 6) + (ln & 31);
#pragma unroll
    for (int p = 0; p < 6; ++p) { const int pos = q0 - 128 + p * 64 + srow; k6[p] = (v4u){0u, 0u, 0u, 0u}; v6[p] = (v4u){0u, 0u, 0u, 0u};
        if (pos >= 0) { k6[p] = *(const v4u*)(kg + (size_t)pos * 64 + 8 * scc); v6[p] = *(const v4u*)(vg + (size_t)pos * 64 + 8 * scc); } }
#pragma unroll
    for (int ds = 0; ds < 4; ++ds) qw[ds] = *(const v4u*)(qg + (size_t)qpos * 64 + 16 * ds + 8 * (ln >> 5));
}
__device__ __forceinline__ void sb_unit(LAS unsigned char* lds, const bf16* qg, const bf16* kg, const bf16* vg, int q0, bf16* og, int tid_, int lane_, int wave,
                                        v4u (&k6)[6], v4u (&v6)[6], v4u (&qwd)[4], bool has_next, const bf16* nqg, const bf16* nkg, const bf16* nvg, int nq0) {
    int lane = lane_; asm volatile("" : "+v"(lane)); const int tid = wave * 64 + lane; (void)tid_;
    constexpr int CB = 128 * KP;
    LAS unsigned char* Kl = lds; LAS unsigned char* Vl = lds + 384 * KP; LAS int* flags = (LAS int*)(lds + 2 * 384 * KP + 8192);
    const int r = lane & 31, h = lane >> 5, qw = q0 + 32 * wave, qpos = qw + r;
    const int srow = tid >> 3, scc = tid & 7;
    __syncthreads();
#pragma unroll
    for (int p = 0; p < 6; ++p) { *(LAS v4u*)(Kl + (p * 64 + srow) * KP + 16 * scc) = k6[p]; *(LAS v4u*)(Vl + (p * 64 + srow) * KP + 16 * scc) = v6[p]; }
    bf16x8 qf[4];
#pragma unroll
    for (int ds = 0; ds < 4; ++ds) { float f[8]; UNPACK8(qwd[ds], f);
        v4u o; o.x = pk2(f[0] * 0.125f, f[1] * 0.125f); o.y = pk2(f[2] * 0.125f, f[3] * 0.125f); o.z = pk2(f[4] * 0.125f, f[5] * 0.125f); o.w = pk2(f[6] * 0.125f, f[7] * 0.125f);
        qf[ds] = __builtin_bit_cast(bf16x8, o); }
    __syncthreads();
    if (has_next) sb_fetch(nqg, nkg, nvg, nq0, tid, k6, v6, qwd);
    float R = 1.f; bool wdone = false;
    f32x16 o[2];
#pragma unroll
    for (int i = 0; i < 16; ++i) { o[0][i] = 0.f; o[1][i] = 0.f; }
    {
        const LAS unsigned char* ka = Kl + kvperm(r) * KP + 16 * h;
        const LAS unsigned char* va = Vl + (16 * h + ((lane & 15) >> 2)) * KP + ((lane >> 4) & 1) * 32 + (lane & 3) * 8;
        for (int tl = 4 + wave; tl >= 0; --tl) {
            if (q0 - 128 + 32 * tl < 0) break;
            sb_tile(ka + tl * 32 * KP, va + tl * 32 * KP, tl == 4 + wave, r, h, qf, R, o);
            if (__all(R < 1e-36f)) { wdone = true; break; }
        }
    }
    int kc = q0 - 256; const int nch = (q0 >= 256) ? (q0 - 128) / 128 : 0;
    if (lane == 0) flags[16 + wave] = wdone ? 1 : 0;
    __syncthreads();
    { int alld = 1;
#pragma unroll
      for (int w = 0; w < 8; ++w) alld &= flags[16 + w];
      if (!alld && nch > 0) {
        LAS unsigned char* Kb = lds; LAS unsigned char* Vb = lds + 2 * CB;
        v4u kr[2], vr[2];
#pragma unroll
        for (int p = 0; p < 2; ++p) { kr[p] = *(const v4u*)(kg + (size_t)(kc + srow + 64 * p) * 64 + 8 * scc); vr[p] = *(const v4u*)(vg + (size_t)(kc + srow + 64 * p) * 64 + 8 * scc); }
#pragma unroll
        for (int p = 0; p < 2; ++p) { *(LAS v4u*)(Kb + (srow + 64 * p) * KP + 16 * scc) = kr[p]; *(LAS v4u*)(Vb + (srow + 64 * p) * KP + 16 * scc) = vr[p]; }
        __syncthreads();
        for (int ch = 0; ch < nch; ++ch) {
            const int buf = ch & 1; const bool has_next = ch + 1 < nch;
            if (has_next) {
#pragma unroll
                for (int p = 0; p < 2; ++p) { kr[p] = *(const v4u*)(kg + (size_t)(kc - 128 + srow + 64 * p) * 64 + 8 * scc); vr[p] = *(const v4u*)(vg + (size_t)(kc - 128 + srow + 64 * p) * 64 + 8 * scc); }
            }
            if (!wdone) {
                const LAS unsigned char* ka = Kb + buf * CB + kvperm(r) * KP + 16 * h;
                const LAS unsigned char* va = Vb + buf * CB + (16 * h + ((lane & 15) >> 2)) * KP + ((lane >> 4) & 1) * 32 + (lane & 3) * 8;
                for (int tt = 3; tt >= 0; --tt) { sb_tile(ka + tt * 32 * KP, va + tt * 32 * KP, false, r, h, qf, R, o); if (__all(R < 1e-36f)) { wdone = true; break; } }
            }
            if (has_next) {
#pragma unroll
                for (int p = 0; p < 2; ++p) { *(LAS v4u*)(Kb + (buf ^ 1) * CB + (srow + 64 * p) * KP + 16 * scc) = kr[p]; *(LAS v4u*)(Vb + (buf ^ 1) * CB + (srow + 64 * p) * KP + 16 * scc) = vr[p]; }
            }
            if (lane == 0) flags[buf * 8 + wave] = wdone ? 1 : 0;
            __syncthreads();
            int alld2 = 1;
#pragma unroll
            for (int w = 0; w < 8; ++w) alld2 &= flags[buf * 8 + w];
            if (alld2) break;
            kc -= 128;
        }
      } }
    store_ot(og + (size_t)qpos * 64, o, 1.0f, h);
}
struct Args { const float* in[16]; float* out; unsigned char* ws; };

__device__ __forceinline__ void transpose_item(const float* W, int K, int N, bf16* WT, LAS float* scr, int item, int lane, bool perm_up = false, const float* gk = nullptr, bool perm_in = false) {
    const int nblk = N / 32, kb = item / nblk, nb = item % nblk, k0 = 64 * kb, n0 = 32 * nb;
    int d0 = n0; if (perm_up) { const int bj = n0 / DFF, ch = n0 % DFF; d0 = 256 * (ch >> 7) + 128 * bj + (ch & 127); }
    if (perm_in) { const int o = n0 & 255; d0 = (n0 & ~255) + 128 * ((o >> 5) & 1) + 32 * (o >> 6); }
    float wv[32];
#pragma unroll
    for (int i = 0; i < 32; ++i) wv[i] = W[(size_t)(k0 + 2 * i + (lane >> 5)) * N + n0 + (lane & 31)];
#pragma unroll
    for (int i = 0; i < 32; ++i) scr[(2 * i + (lane >> 5)) * 33 + (lane & 31)] = wv[i];
    LDS_WAIT(); asm volatile("" ::: "memory");
    const int c = lane & 7;
    f32x4 ga = {1.f, 1.f, 1.f, 1.f}, gb = {1.f, 1.f, 1.f, 1.f}; if (gk) { ga = *(const f32x4*)(gk + k0 + 8 * c); gb = *(const f32x4*)(gk + k0 + 8 * c + 4); }
#pragma unroll
    for (int j = 0; j < 4; ++j) { const int n = (lane >> 3) + 8 * j; const LAS float* s = scr + (8 * c) * 33 + n;
        v4u o; o.x = pk2(s[0 * 33] * ga.x, s[1 * 33] * ga.y); o.y = pk2(s[2 * 33] * ga.z, s[3 * 33] * ga.w); o.z = pk2(s[4 * 33] * gb.x, s[5 * 33] * gb.y); o.w = pk2(s[6 * 33] * gb.z, s[7 * 33] * gb.w);
        *(v4u*)(WT + (size_t)(d0 + n) * K + k0 + 8 * c) = o; }
    LDS_WAIT(); asm volatile("" ::: "memory");
}
__device__ __forceinline__ void rms_row(const float* xrow, const float* g, bf16* orow, int lane) {
    const f32x4* xr = (const f32x4*)xrow + lane; const f32x4* gr = (const f32x4*)g + lane;
    f32x4 v[8]; float s = 0.f;
#pragma unroll
    for (int j = 0; j < 8; ++j) { v[j] = xr[64 * j]; s += (v[j].x * v[j].x + v[j].y * v[j].y) + (v[j].z * v[j].z + v[j].w * v[j].w); }
    const float rstd = 1.0f / sqrtf(wave_sum(s) * (1.0f / DM) + EPS);
    unsigned long long* o8 = (unsigned long long*)orow + lane;
#pragma unroll
    for (int j = 0; j < 8; ++j) { const f32x4 gv = gr[64 * j];
        o8[64 * j] = (unsigned long long)pk2(v[j].x * rstd * gv.x, v[j].y * rstd * gv.y) | ((unsigned long long)pk2(v[j].z * rstd * gv.z, v[j].w * rstd * gv.w) << 32); }
}
__device__ __forceinline__ void xrow_prep(const float* xrow, bf16* orow, float* rs, int lane) {
    const f32x4* xr = (const f32x4*)xrow + lane; f32x4 v[8]; float s = 0.f;
#pragma unroll
    for (int j = 0; j < 8; ++j) { v[j] = xr[64 * j]; s += (v[j].x * v[j].x + v[j].y * v[j].y) + (v[j].z * v[j].z + v[j].w * v[j].w); }
    s = wave_sum(s);
    unsigned long long* o8 = (unsigned long long*)orow + lane;
#pragma unroll
    for (int j = 0; j < 8; ++j) o8[64 * j] = (unsigned long long)pk2(v[j].x, v[j].y) | ((unsigned long long)pk2(v[j].z, v[j].w) << 32);
    if (lane == 0) *rs = 1.0f / sqrtf(s * (1.0f / DM) + EPS);
}
__device__ __forceinline__ void rstd_pass(const float* slots, float* rstd, int gtid, int nthreads) {
    for (int row = gtid; row < MTOK; row += nthreads) { const f32x4* p = (const f32x4*)(slots + (size_t)row * 32); f32x4 a = p[0];
#pragma unroll
        for (int j = 1; j < 8; ++j) a = a + p[j];
        rstd[row] = 1.0f / sqrtf(((a.x + a.y) + (a.z + a.w)) * (1.0f / DM) + EPS); }
}
__device__ __forceinline__ int t5_bucket(int d) {
    if (d < 16) return d;
    const float v = logf((float)d / 16.0f) / 4.852030263919617f * 16.0f;
    const int large = 16 + (int)v;
    return large < 31 ? large : 31;
}
__device__ __forceinline__ float red8(float v) { return red8_dpp(v); }
__device__ __forceinline__ void finalize8(const bf16* att, const float* lse, const float* g, bf16* mix, int tok0, int lane_) {
    int lane = lane_; asm volatile("" : "+v"(lane));
    const int ts = lane >> 3, ck = lane & 7, tok = tok0 + ts, t0 = tok0 & (SEQ - 1);
    const int b = __builtin_amdgcn_readfirstlane(tok0 >> 12);
    const char* ab = (const char*)(att + ((size_t)b * 64) * SEQ * 64 + (size_t)t0 * 64);
    const unsigned lo = (unsigned)(ts * 64 + 8 * ck) * 2u;
    bf16* mr = mix + (size_t)tok * DM + 8 * ck;
#pragma unroll
    for (int grp = 0; grp < 2; ++grp) {
        v4u w[8]; float ss = 0.f;
#pragma unroll
        for (int s = 0; s < 8; ++s) { w[s] = *(const v4u*)(ab + (size_t)(8 * grp + s) * SEQ * 128 + lo); float f[8]; UNPACK8(w[s], f);
#pragma unroll
            for (int e = 0; e < 8; ++e) ss += f[e] * f[e]; }
        const float rn = 1.0f / sqrtf(red8(ss) * (1.0f / 512.0f) + EPS);
#pragma unroll
        for (int s = 0; s < 8; ++s) { float f[8]; UNPACK8(w[s], f); const float* gg = g + 512 * grp + 64 * s + 8 * ck; const f32x4 g0 = *(const f32x4*)gg, g1 = *(const f32x4*)(gg + 4);
            v4u o; o.x = pk2(f[0] * rn * g0.x, f[1] * rn * g0.y); o.y = pk2(f[2] * rn * g0.z, f[3] * rn * g0.w); o.z = pk2(f[4] * rn * g1.x, f[5] * rn * g1.y); o.w = pk2(f[6] * rn * g1.z, f[7] * rn * g1.w);
            *(v4u*)(mr + 512 * grp + 64 * s) = o; }
        asm volatile("" ::: "memory");
    }
    {
        v4u cpk[16]; float ss = 0.f;
        const float* lp = lse + (size_t)tok * 16;
#pragma unroll
        for (int hh = 0; hh < 16; ++hh) {
            float ls[3], mx = -1e30f;
#pragma unroll
            for (int br = 0; br < 3; ++br) { ls[br] = lp[(size_t)br * MTOK * 16 + hh]; mx = fmaxf(mx, ls[br]); }
            float wsum = 0.f;
#pragma unroll
            for (int br = 0; br < 3; ++br) { ls[br] = __expf(ls[br] - mx); wsum += ls[br]; }
            const float winv = __builtin_amdgcn_rcpf(wsum);
            float c[8];
#pragma unroll
            for (int e = 0; e < 8; ++e) c[e] = 0.f;
#pragma unroll
            for (int br = 0; br < 3; ++br) { const v4u w = *(const v4u*)(ab + (size_t)(16 + 16 * br + hh) * SEQ * 128 + lo); float f[8]; UNPACK8(w, f); const float wb = ls[br] * winv;
#pragma unroll
                for (int e = 0; e < 8; ++e) c[e] += wb * f[e]; }
#pragma unroll
            for (int e = 0; e < 8; ++e) ss += c[e] * c[e];
            cpk[hh].x = pk2(c[0], c[1]); cpk[hh].y = pk2(c[2], c[3]); cpk[hh].z = pk2(c[4], c[5]); cpk[hh].w = pk2(c[6], c[7]);
            if (hh & 1) asm volatile("" ::: "memory");
        }
        const float rn = 1.0f / sqrtf(red8(ss) * (1.0f / 1024.0f) + EPS);
#pragma unroll
        for (int hh = 0; hh < 16; ++hh) { float c[8]; UNPACK8(cpk[hh], c); const float* gg = g + 1024 + 64 * hh + 8 * ck; const f32x4 g0 = *(const f32x4*)gg, g1 = *(const f32x4*)(gg + 4);
            v4u o; o.x = pk2(c[0] * rn * g0.x, c[1] * rn * g0.y); o.y = pk2(c[2] * rn * g0.z, c[3] * rn * g0.w); o.z = pk2(c[4] * rn * g1.x, c[5] * rn * g1.y); o.w = pk2(c[6] * rn * g1.z, c[7] * rn * g1.w);
            *(v4u*)(mr + 1024 + 64 * hh) = o;
            if (hh & 1) asm volatile("" ::: "memory"); }
    }
}
__device__ __forceinline__ void conv_item(const bf16* u, const float* cw, const float* cb, bf16* act, int item, int lane) {
    const int slab = item % 11, chunk = item / 11, f0 = slab * 512 + lane * 8, tok0 = chunk * 64;
    float wg[3][8], wu[3][8], bg[8], bu[8];
#pragma unroll
    for (int i = 0; i < 3; ++i)
#pragma unroll
        for (int e = 0; e < 8; ++e) { wg[i][e] = cw[i * UW + f0 + e]; wu[i][e] = cw[i * UW + DFF + f0 + e]; }
#pragma unroll
    for (int e = 0; e < 8; ++e) { bg[e] = cb[f0 + e]; bu[e] = cb[DFF + f0 + e]; }
    float g1[8], g2[8], u1[8], u2[8];
    if ((tok0 & (SEQ - 1)) == 0) {
#pragma unroll
        for (int e = 0; e < 8; ++e) { g1[e] = 0.f; g2[e] = 0.f; u1[e] = 0.f; u2[e] = 0.f; }
    } else {
        const bf16* r1 = u + (size_t)(tok0 - 1) * UW + f0; const bf16* r2 = u + (size_t)(tok0 - 2) * UW + f0;
        { const v4u w = *(const v4u*)r1; UNPACK8(w, g1); } { const v4u w = *(const v4u*)(r1 + DFF); UNPACK8(w, u1); }
        { const v4u w = *(const v4u*)r2; UNPACK8(w, g2); } { const v4u w = *(const v4u*)(r2 + DFF); UNPACK8(w, u2); }
    }
#pragma unroll 4
    for (int t = 0; t < 64; ++t) {
        const bf16* r0 = u + (size_t)(tok0 + t) * UW + f0;
        float g0[8], u0[8], o[8];
        { const v4u w = *(const v4u*)r0; UNPACK8(w, g0); } { const v4u w = *(const v4u*)(r0 + DFF); UNPACK8(w, u0); }
#pragma unroll
        for (int e = 0; e < 8; ++e) {
            const float gv = bg[e] + wg[0][e] * g2[e] + wg[1][e] * g1[e] + wg[2][e] * g0[e];
            const float uv = bu[e] + wu[0][e] * u2[e] + wu[1][e] * u1[e] + wu[2][e] * u0[e];
            o[e] = gv / (1.0f + __expf(-gv)) * uv;
            g2[e] = g1[e]; g1[e] = g0[e]; u2[e] = u1[e]; u1[e] = u0[e];
        }
        v4u ov; ov.x = pk2(o[0], o[1]); ov.y = pk2(o[2], o[3]); ov.z = pk2(o[4], o[5]); ov.w = pk2(o[6], o[7]);
        *(v4u*)(act + (size_t)(tok0 + t) * DFF + f0) = ov;
    }
}

#ifndef REV_DOWN
#define REV_DOWN 1
#endif
#ifndef REV_ATT
#define REV_ATT 1
#endif
#ifndef WGM_IN
#define WGM_IN 4
#define WGM_OUT 4
#define WGM_UP 4
#define WGM_DOWN 4
#endif
#define PHASE_BEGIN() \
    int zs_ = 0; asm volatile("" : "+s"(zs_)); zs_ = __builtin_amdgcn_readfirstlane(zs_);     \
    const Args* ap = (const Args*)((const char*)__builtin_amdgcn_kernarg_segment_ptr() + zs_); \
    unsigned lz_ = 0u; asm volatile("" : "+v"(lz_)); const int lane = __builtin_amdgcn_mbcnt_hi(~0u, __builtin_amdgcn_mbcnt_lo(~0u, lz_)); \
    const int wave = wave_s + zs_, G = (int)gridDim.x + zs_, bx = (int)blockIdx.x + zs_; \
    const int tid = wave * 64 + lane; const int gw = bx * NWAVES + wave, NGW = G * NWAVES; \
    unsigned char* ws = ap->ws; (void)tid; (void)gw; (void)NGW; (void)ws
#define GRID_BAR() do { int zb_ = 0; asm volatile("" : "+s"(zb_)); zb_ = __builtin_amdgcn_readfirstlane(zb_); const Args* apb_ = (const Args*)((const char*)__builtin_amdgcn_kernarg_segment_ptr() + zb_); \
    XcdBarrier b_; b_.bar = (unsigned*)(apb_->ws + WS_CTL); b_.x = xb_xcc_id(); b_.st = (volatile LAS unsigned*)(lds + 131072); xcd_barrier(b_, wave_s + zb_); } while (0)
__global__ void __launch_bounds__(NWAVES * 64, 2) fwd_mega(Args args_unused) {
    extern __shared__ __attribute__((aligned(16))) unsigned char lds_raw[];
    cg::grid_group grid = cg::this_grid();
    LAS unsigned char* lds = (LAS unsigned char*)lds_raw;
    const int wave_s = __builtin_amdgcn_readfirstlane(threadIdx.x >> 6);
    volatile LAS unsigned* bar_st = (volatile LAS unsigned*)(lds + 131072);
    if (threadIdx.x < 2) bar_st[threadIdx.x] = 0u;
    __syncthreads();
    { const Args* ap0 = (const Args*)__builtin_amdgcn_kernarg_segment_ptr(); (void)xcd_barrier_post((unsigned*)(ap0->ws + WS_CTL), bar_st); }

#pragma nounroll
    for (int l = 0; l < DEPTH; ++l) {
        {
            PHASE_BEGIN();
            LAS float* scr = (LAS float*)(lds + wave * 16384);
            const float* w_in = ap->in[2] + (size_t)l * DM * PW; bf16* Wt_in = (bf16*)(ws + WS_WIN);
            constexpr int I_IN = (DM / 64) * (PW / 32);
            for (int it = gw; it < I_IN; it += NGW) transpose_item(w_in, DM, PW, Wt_in, scr, it, lane, false, ap->in[1] + (size_t)l * DM, true);
            if (l == 0) { const float* xin = ap->in[0]; bf16* XB1 = (bf16*)(ws + WS_R2); float* RSTD1 = (float*)(ws + WS_RSTD1);
              for (int m = gw; m < MTOK; m += NGW) xrow_prep(xin + (size_t)m * DM, XB1 + (size_t)m * DM, RSTD1 + m, lane); }
            else rstd_pass((const float*)(ws + WS_RS1), (float*)(ws + WS_RSTD1), bx * 512 + tid, G * 512);
            if (l == 0) { float* B2 = (float*)(ws + WS_BIAS); const float* rel_tab = ap->in[8];
                for (int i = bx * 512 + tid; i < 4 * 16 * 160; i += G * 512) { const int cfg = i / 2560, rr = i % 2560, hh = rr / 160, j = rr % 160; const int dil = cfg <= 1 ? 1 : (cfg == 2 ? 4 : 16);
                    float v = 0.f; if (j <= 128) { if (cfg == 0) { if (hh < 8) v = rel_tab[t5_bucket(j) * 24 + hh]; } else v = rel_tab[t5_bucket(j * dil) * 24 + 8 + hh]; }
                    B2[i] = v * LOG2E; } }
            if (bx == 0 && tid < 128) { float* GQ = (float*)(ws + WS_GQK);
                GQ[tid] = tid < 64 ? ap->in[3][l * 64 + tid] * ap->in[4][l * 64 + tid] : ap->in[6][l * 64 + tid - 64] * ap->in[7][l * 64 + tid - 64]; }
        }
        if (l == 0) grid.sync(); else GRID_BAR();
        {
            PHASE_BEGIN();
            pg8::Gemm g{(const bf16*)(ws + WS_R2), (const bf16*)(ws + WS_WIN), MTOK, PW, DM}; pg8::StaticOrder S; S.init(MTOK, PW, G, bx, WGM_IN);
            pg8::EpiBf16s E{(bf16*)(ws + WS_R1), (const float*)(ws + WS_RSTD1), ap->in[3] + l * 64, ap->in[4] + l * 64, ap->in[6] + l * 64, ap->in[7] + l * 64};
            pg8::gemm_phase<pg8::EpiBf16s, pg8::StaticOrder, true, true>(lds, g, S, E, tid);
            { constexpr int NT_IN = (MTOK / 256) * (PW / 256); const int nfull = NT_IN % G;
              if (nfull > 0 && bx >= nfull) {
                  LAS float* scr = (LAS float*)(lds + wave * 16384);
                  const float* w_out = ap->in[10] + (size_t)l * DM * DM; const float* w_down = ap->in[15] + (size_t)l * DFF * DM; const float* w_up = ap->in[12] + (size_t)l * DM * UW;
                  bf16* Wt_out = (bf16*)(ws + WS_WOUT); bf16* Wt_down = (bf16*)(ws + WS_WDOWN); bf16* Wt_up = (bf16*)(ws + WS_WUP);
                  constexpr int I_OUT = (DM / 64) * (DM / 32), I_DOWN = (DFF / 64) * (DM / 32), I_UP = (DM / 64) * (UW / 32);
                  const int nw = (G - nfull) * NWAVES;
                  for (int it = (bx - nfull) * NWAVES + wave; it < I_OUT + I_DOWN + I_UP; it += nw) {
                      if (it < I_OUT) transpose_item(w_out, DM, DM, Wt_out, scr, it, lane); else if (it < I_OUT + I_DOWN) transpose_item(w_down, DFF, DM, Wt_down, scr, it - I_OUT, lane);
                      else transpose_item(w_up, DM, UW, Wt_up, scr, it - I_OUT - I_DOWN, lane, true, ap->in[11] + (size_t)l * DM); }
              } else if (nfull == 0) {
                  LAS float* scr = (LAS float*)(lds + wave * 16384);
                  const float* w_out = ap->in[10] + (size_t)l * DM * DM; const float* w_down = ap->in[15] + (size_t)l * DFF * DM; const float* w_up = ap->in[12] + (size_t)l * DM * UW;
                  bf16* Wt_out = (bf16*)(ws + WS_WOUT); bf16* Wt_down = (bf16*)(ws + WS_WDOWN); bf16* Wt_up = (bf16*)(ws + WS_WUP);
                  constexpr int I_OUT = (DM / 64) * (DM / 32), I_DOWN = (DFF / 64) * (DM / 32), I_UP = (DM / 64) * (UW / 32);
                  for (int it = gw; it < I_OUT + I_DOWN + I_UP; it += NGW) {
                      if (it < I_OUT) transpose_item(w_out, DM, DM, Wt_out, scr, it, lane); else if (it < I_OUT + I_DOWN) transpose_item(w_down, DFF, DM, Wt_down, scr, it - I_OUT, lane);
                      else transpose_item(w_up, DM, UW, Wt_up, scr, it - I_OUT - I_DOWN, lane, true, ap->in[11] + (size_t)l * DM); }
              } }
        }
        GRID_BAR();
        {
            PHASE_BEGIN();
            const bf16* PROJ = (const bf16*)(ws + WS_R1); bf16* ATT = (bf16*)(ws + WS_ATT); float* LSE = (float*)(ws + WS_LSE);
            const float* B2 = (const float*)(ws + WS_BIAS); const float* GQ = (const float*)(ws + WS_GQK); const float* a_sinks = ap->in[5] + l * 8;
            int u = bx;
            if (u < 1024) {
                v4u k6[6], v6[6], qw[4];
#define SB_DECODE(U, PB, Q0, OG) const int b_##PB = REV_ATT ? 7 - ((U) >> 7) : ((U) >> 7), hh_##PB = ((U) >> 4) & 7; const bf16* PB = PROJ + ((size_t)b_##PB * 84 + hh_##PB) * SEQ * 64; \
                const int Q0 = ((U) & 15) * 256; bf16* OG = ATT + ((size_t)b_##PB * 64 + 8 + hh_##PB) * SEQ * 64
                { SB_DECODE(u, pb0, q00, og0); (void)og0; sb_fetch(pb0 + (size_t)12 * SEQ * 64, pb0 + (size_t)20 * SEQ * 64, pb0 + (size_t)28 * SEQ * 64, q00, tid, k6, v6, qw); }
                for (;;) { const int un = u + G; const bool has_next = un < 1024; const int unc = has_next ? un : u;
                    SB_DECODE(u, pbc, q0c, ogc); SB_DECODE(unc, pbn, q0n, ogn); (void)ogn;
                    sb_unit(lds, pbc + (size_t)12 * SEQ * 64, pbc + (size_t)20 * SEQ * 64, pbc + (size_t)28 * SEQ * 64, q0c, ogc, tid, lane, wave, k6, v6, qw, has_next,
                            pbn + (size_t)12 * SEQ * 64, pbn + (size_t)20 * SEQ * 64, pbn + (size_t)28 * SEQ * 64, q0n);
                    u = un; if (!has_next) break; }
#undef SB_DECODE
            }
            if (u < 8192) {
                v4u kr[6], vr[6], qw[4]; float bv;
                LAS float* gqkL = (LAS float*)(lds + 2 * 384 * KP + 384 * 4 + 192 * 4);
                if (tid < 128) gqkL[tid] = GQ[tid];
                BandCfg c = band_cfg(u, PROJ, ATT, LSE, B2, GQ, a_sinks);
                band_fetch(c, tid, kr, vr, bv, qw);
                for (;;) { const int un = u + G; const bool has_next = un < 8192;
                    BandCfg cn = c;
                    banded_unit(lds, c, tid, lane, wave, kr, vr, bv, qw, gqkL + c.gqk, has_next, un, cn, PROJ, ATT, LSE, B2, a_sinks);
                    if (!has_next) break;
                    c = cn; u = un; }
            }
            __syncthreads();
        }
        GRID_BAR();
        { PHASE_BEGIN(); const float* mix_gain = ap->in[9] + (size_t)l * DM; const bf16* ATT = (const bf16*)(ws + WS_ATT); const float* LSE = (const float*)(ws + WS_LSE); bf16* MIX = (bf16*)(ws + WS_MIX);
          for (int m8 = gw; m8 < MTOK / 8; m8 += NGW) finalize8(ATT, LSE, mix_gain, MIX, m8 * 8, lane); }
        GRID_BAR();
        {
            PHASE_BEGIN();
            pg8::Gemm g{(const bf16*)(ws + WS_MIX), (const bf16*)(ws + WS_WOUT), MTOK, DM, DM}; pg8::StaticOrder S; S.init(MTOK, DM, G, bx, WGM_OUT);
            pg8::EpiRes E{(l == 0) ? ap->in[0] : (const float*)nullptr, (const bf16*)(ws + WS_R2), (float*)nullptr, (bf16*)(ws + WS_XB2), (float*)(ws + WS_RS2), DM};
            pg8::gemm_phase<pg8::EpiRes, pg8::StaticOrder, true, true>(lds, g, S, E, tid);
        }
        GRID_BAR();
        { PHASE_BEGIN(); rstd_pass((const float*)(ws + WS_RS2), (float*)(ws + WS_RSTD2), bx * 512 + tid, G * 512); }
        GRID_BAR();
        {
            PHASE_BEGIN();
            pg8::Gemm g{(const bf16*)(ws + WS_XB2), (const bf16*)(ws + WS_WUP), MTOK, UW, DM}; pg8::StaticOrder S; S.init(MTOK, UW, G, bx, WGM_UP);
            pg8::EpiConvGate E{(bf16*)(ws + WS_R1), ap->in[13] + (size_t)l * 3 * UW, ap->in[14] + (size_t)l * UW, (float*)(ws + WS_UH), (LAS float*)(lds + LDS_XCH), (const float*)(ws + WS_RSTD2)};
            pg8::gemm_phase<pg8::EpiConvGate, pg8::StaticOrder, true, true>(lds, g, S, E, tid);
        }
        GRID_BAR();
        { PHASE_BEGIN(); const float* cw = ap->in[13] + (size_t)l * 3 * UW; const float* cb = ap->in[14] + (size_t)l * UW; const float* uh = (const float*)(ws + WS_UH); bf16* ACT = (bf16*)(ws + WS_R1);
          for (int idx = bx * 512 + tid; idx < 128 * DFF; idx += G * 512) { const int pm = idx / DFF, ch = idx % DFF; if ((pm & 15) == 0) continue;
              const int pos = 256 * (ch >> 7) + (ch & 127); const float* a = uh + (size_t)(pm - 1) * 4 * UW + pos; const float* b = uh + (size_t)pm * 4 * UW + pos;
              const float gm2 = a[2 * UW], gm1 = a[3 * UW], g0 = b[0], g1 = b[UW], um2 = a[2 * UW + 128], um1 = a[3 * UW + 128], u0 = b[128], u1 = b[UW + 128];
              const float wg0 = cw[ch], wg1 = cw[UW + ch], wg2 = cw[2 * UW + ch], wu0 = cw[DFF + ch], wu1 = cw[UW + DFF + ch], wu2 = cw[2 * UW + DFF + ch], bg = cb[ch], bu = cb[DFF + ch];
              { const float gv = bg + wg0 * gm2 + wg1 * gm1 + wg2 * g0, uv = bu + wu0 * um2 + wu1 * um1 + wu2 * u0; ACT[(size_t)(pm * 256) * DFF + ch] = (bf16)f2bf(gv / (1.0f + __expf(-gv)) * uv); }
              { const float gv = bg + wg0 * gm1 + wg1 * g0 + wg2 * g1, uv = bu + wu0 * um1 + wu1 * u0 + wu2 * u1; ACT[(size_t)(pm * 256 + 1) * DFF + ch] = (bf16)f2bf(gv / (1.0f + __expf(-gv)) * uv); } } }
        GRID_BAR();
        {
            PHASE_BEGIN();
            pg8::Gemm g{(const bf16*)(ws + WS_R1), (const bf16*)(ws + WS_WDOWN), MTOK, DM, DFF}; pg8::StaticOrder S; S.init(MTOK, DM, G, bx, WGM_DOWN, REV_DOWN);
            pg8::EpiRes E{(const float*)nullptr, (const bf16*)(ws + WS_XB2), (l == DEPTH - 1) ? ap->out : (float*)nullptr, (bf16*)(ws + WS_R2), (float*)(ws + WS_RS1), DM};
            pg8::gemm_phase<pg8::EpiRes, pg8::StaticOrder, true, true>(lds, g, S, E, tid);
        }
        if (l + 1 < DEPTH) GRID_BAR();
    }
}

extern "C" void kernel_launch(void* const* d_in, const int* in_sizes, int n_in, void* d_out, int out_size, void* d_ws, size_t ws_size, hipStream_t stream) {
    static int grid = 0;
    if (grid == 0) {
        if (n_in != 16 || out_size != MTOK * DM || ws_size < WS_END) { fprintf(stderr, "kernel_launch: unexpected shapes (n_in %d out %d ws %zu)\n", n_in, out_size, ws_size); grid = -1; return; }
        int dev = 0, cus = 0, per_cu = 0;
        (void)hipGetDevice(&dev); (void)hipDeviceGetAttribute(&cus, hipDeviceAttributeMultiprocessorCount, dev);
        if (hipFuncSetAttribute((const void*)fwd_mega, hipFuncAttributeMaxDynamicSharedMemorySize, LDS_BYTES) != hipSuccess) { fprintf(stderr, "kernel_launch: hipFuncSetAttribute failed\n"); grid = -1; return; }
        if (hipOccupancyMaxActiveBlocksPerMultiprocessor(&per_cu, (const void*)fwd_mega, NWAVES * 64, LDS_BYTES) != hipSuccess || per_cu < 1) { fprintf(stderr, "kernel_launch: occupancy query says %d\n", per_cu); per_cu = 1; }
        (void)hipGetLastError();
        grid = cus * per_cu;
        fprintf(stderr, "kernel_launch: grid %d (cus %d x %d)\n", grid, cus, per_cu);
    }
    if (grid < 0) return;
    if (hipMemsetAsync((char*)d_ws + WS_CTL, 0, 16384, stream) != hipSuccess) { fprintf(stderr, "kernel_launch: memset of barrier words failed\n"); return; }
    Args a{};
    for (int i = 0; i < 16; ++i) a.in[i] = (const float*)d_in[i];
    a.out = (float*)d_out; a.ws = (unsigned char*)d_ws;
    void* kargs[] = {&a};
    hipError_t e = hipLaunchCooperativeKernel((const void*)fwd_mega, dim3(grid), dim3(NWAVES * 64), kargs, LDS_BYTES, stream);
    if (e != hipSuccess) fprintf(stderr, "cooperative launch failed: %s (grid %d)\n", hipGetErrorString(e), grid);
}
```
